# Optimizing an MI355X kernel written in HIP

```python
import jax, jax.numpy as jnp
from jax import lax
import numpy as np

D_MODEL = 2048
BATCH = 4
SEQ = 4096
DEPTH = 2

D_MIX = D_MODEL
WIDTH_A = D_MIX // 2
WIDTH_B = D_MIX - WIDTH_A
CHUNK = 128
HEADS_A = 8
DH_A = WIDTH_A // HEADS_A
HEADS_B = 16
DH_B = WIDTH_B // HEADS_B
Q_BLOCK = 128
EPS = 1e-6
SPLIT_SIZES = (WIDTH_A, WIDTH_A, WIDTH_A, WIDTH_B, WIDTH_B, WIDTH_B, WIDTH_B, HEADS_B)
D_IN = sum(SPLIT_SIZES)

kernel_name = "hybrid_gmlp_forgetting_attn_block"


def _split_points(sizes):
    pts, acc = [], 0
    for s in sizes[:-1]:
        acc += s
        pts.append(acc)
    return pts


def rms_norm(x, g):
    xf = x.astype(jnp.float32)
    y = xf * lax.rsqrt(jnp.mean(xf * xf, axis=-1, keepdims=True) + EPS)
    return (y * g.astype(jnp.float32)).astype(x.dtype)


def layer_norm(x, g, b):
    xf = x.astype(jnp.float32)
    mu = jnp.mean(xf, axis=-1, keepdims=True)
    xc = xf - mu
    var = jnp.mean(xc * xc, axis=-1, keepdims=True)
    y = xc * lax.rsqrt(var + EPS) * g.astype(jnp.float32) + b.astype(jnp.float32)
    return y.astype(x.dtype)


def chunked_spatial_gating(u, v, ln_g, ln_b, w_s, b_s):
    bsz, s, _ = v.shape
    n = s // CHUNK
    v = layer_norm(v, ln_g, ln_b)
    vc = v.reshape(bsz, n, CHUNK, HEADS_A, DH_A)
    causal = jnp.tril(jnp.ones((CHUNK, CHUNK), dtype=bool))
    w = jnp.where(causal[None], w_s, jnp.zeros_like(w_s))
    mixed = jnp.einsum('hts,bnshd->bnthd', w, vc) + b_s.T[None, None, :, :, None]
    return u * mixed.reshape(bsz, s, WIDTH_A)


def forgetting_attention(q, k, v, f_logit, b_f):
    bsz, s, _ = q.shape
    nb = s // Q_BLOCK
    to_heads = lambda t: t.reshape(bsz, s, HEADS_B, DH_B).transpose(0, 2, 1, 3)
    q, k, v = to_heads(q), to_heads(k), to_heads(v)
    log_f = jax.nn.log_sigmoid(f_logit.astype(jnp.float32) + b_f.astype(jnp.float32))
    F = jnp.cumsum(log_f, axis=1).transpose(0, 2, 1)
    qb = q.reshape(bsz, HEADS_B, nb, Q_BLOCK, DH_B).transpose(2, 0, 1, 3, 4)
    Fb = F.reshape(bsz, HEADS_B, nb, Q_BLOCK).transpose(2, 0, 1, 3)
    k_pos = jnp.arange(s)
    scale = DH_B ** -0.5

    def block(args):
        qi, Fi, i = args
        q_pos = i * Q_BLOCK + jnp.arange(Q_BLOCK)
        logits = jnp.einsum('bhqd,bhkd->bhqk', qi, k).astype(jnp.float32) * scale
        logits = logits + (Fi[..., :, None] - F[..., None, :])
        logits = jnp.where(q_pos[:, None] >= k_pos[None, :], logits, -jnp.inf)
        p = jax.nn.softmax(logits, axis=-1)
        return jnp.einsum('bhqk,bhkd->bhqd', p.astype(v.dtype), v)

    out = lax.map(block, (qb, Fb, jnp.arange(nb)))
    return out.transpose(1, 0, 3, 2, 4).reshape(bsz, s, WIDTH_B)


def setup_inputs(seed: int = 0) -> dict:
    key = jax.random.key(seed)
    ks = jax.random.split(key, 16)
    f32 = jnp.float32
    nrm = lambda k, shape: jax.random.normal(k, shape, dtype=f32)
    row_scale = (1.0 / jnp.sqrt(jnp.arange(1, CHUNK + 1, dtype=f32)))[None, None, :, None]
    b_f = jnp.linspace(1.0, 5.0, HEADS_B, dtype=f32)[None, :] + 0.1 * nrm(ks[11], (DEPTH, HEADS_B))
    return {
        "x": nrm(ks[0], (BATCH, SEQ, D_MODEL)),
        "c": nrm(ks[1], (BATCH, D_MODEL)),
        "norm_g": 1.0 + 0.1 * nrm(ks[2], (DEPTH, D_MODEL)),
        "w_ada": nrm(ks[3], (DEPTH, D_MODEL, 3 * D_MODEL)) * D_MODEL ** -0.5,
        "b_ada": 0.01 * nrm(ks[4], (DEPTH, 3 * D_MODEL)),
        "w_in": nrm(ks[5], (DEPTH, D_MODEL, D_IN)) * D_MODEL ** -0.5,
        "ln_v_g": 1.0 + 0.1 * nrm(ks[6], (DEPTH, WIDTH_A)),
        "ln_v_b": 0.01 * nrm(ks[7], (DEPTH, WIDTH_A)),
        "w_s": nrm(ks[8], (DEPTH, HEADS_A, CHUNK, CHUNK)) * row_scale,
        "b_s": 1.0 + 0.1 * nrm(ks[9], (DEPTH, HEADS_A, CHUNK)),
        "b_f": b_f,
        "w_out": nrm(ks[10], (DEPTH, D_MIX, D_MODEL)) * D_MIX ** -0.5,
        "final_g": 1.0 + 0.1 * nrm(ks[12], (D_MODEL,)),
    }


def reference(x, c, norm_g, w_ada, b_ada, w_in, ln_v_g, ln_v_b, w_s, b_s, b_f, w_out, final_g):
    cond = jax.nn.silu(c)
    pts = _split_points(SPLIT_SIZES)
    for l in range(DEPTH):
        mod = cond @ w_ada[l] + b_ada[l]
        shift, scale, gate = jnp.split(mod, 3, axis=-1)
        h = rms_norm(x, norm_g[l]) * (1.0 + scale[:, None, :]) + shift[:, None, :]
        z = h @ w_in[l]
        u_a, v_a, g_a, q_b, k_b, v_b, g_b, f_b = jnp.split(z, pts, axis=-1)
        y_a = chunked_spatial_gating(jax.nn.gelu(u_a, approximate=False),
                                     jax.nn.gelu(v_a, approximate=False),
                                     ln_v_g[l], ln_v_b[l], w_s[l], b_s[l]) * jax.nn.silu(g_a)
        y_b = forgetting_attention(q_b, k_b, v_b, f_b, b_f[l]) * jax.nn.silu(g_b)
        y = jnp.concatenate([y_a, y_b], axis=-1) @ w_out[l]
        x = x + gate[:, None, :] * y
    return rms_norm(x, final_g)
```

```cpp
#include <hip/hip_runtime.h>
#include <hip/hip_cooperative_groups.h>
#include <hip/hip_bf16.h>
#include <cstdio>
#include <cstdint>
#include <cmath>
namespace cg = cooperative_groups;
#ifndef PROBE_DUP
#define PROBE_DUP -1
#endif
#ifndef PROBE_REP
#define PROBE_REP 1
#endif
#ifndef PROBE_PART
#define PROBE_PART 0
#endif
#ifndef MK_N_LAUNCHES
#define MK_N_LAUNCHES 1
#endif
namespace pg8 {
#define PG8_LAS __attribute__((address_space(3)))
typedef unsigned short bf16_t;
typedef short bf16x8 __attribute__((ext_vector_type(8)));
typedef float f32x4 __attribute__((ext_vector_type(4)));
typedef unsigned u32x4 __attribute__((ext_vector_type(4)));
constexpr int BM = 256, BK = 64, HALF = 128, HTB = HALF * BK * 2  , STAGE_BYTES = 8 * HTB, NXCD = 8, WGM = 8;

__host__ __device__ __forceinline__ int lds_byte(int r, int c) { const int st = (r >> 4) * 2 + (c >> 5), rr = r & 15, cc = c & 31, ob = rr * 64 + cc * 2; return st * 1024 + (ob ^ (((ob >> 9) & 1) << 5)); }
__host__ __device__ __forceinline__ void stage_rc(int b, int& R, int& C) { const int st = b / 1024, sb = b % 1024, swz = sb ^ (((sb >> 9) & 1) << 5); R = (st >> 1) * 16 + swz / 64; C = (st & 1) * 32 + (swz % 64) / 2; }
__host__ __device__ __forceinline__ int perm32(int rho) { const int n = rho >> 4, i = rho & 15; return 8 * (i >> 2) + 4 * n + (i & 3); }

struct Unit { int pm, pn; };
struct Gemm { const bf16_t* A; const bf16_t* Bt; int M, N, K; };

struct StaticOrder {
    int nM, nN, nwg, G, c;
    __host__ __device__ void init(int M, int N, int G_, int c_) { nM = M / BM; nN = N / BM; nwg = nM * nN; G = G_; c = c_; }
    __host__ __device__ bool next(int i, Unit& u) const {
        const long L = (long)i * G + c; if (L >= nwg) return false;
        int wgid = (int)L; { const int q = nwg / NXCD, r = nwg % NXCD, xcd = wgid % NXCD, off = wgid / NXCD; wgid = (xcd < r ? xcd * (q + 1) : r * (q + 1) + (xcd - r) * q) + off; }
        const int nig = WGM * nN, gid = wgid / nig, fm = gid * WGM, gsz = (nM - fm) < WGM ? (nM - fm) : WGM;
        u.pm = fm + ((wgid % nig) % gsz); u.pn = (wgid % nig) / gsz; return true;
    }
    __device__ __forceinline__ void a_ready(const Unit&) const {}
    __device__ __forceinline__ void done(const Unit&) const {}
};

__device__ __forceinline__ unsigned cvt_pk_bf16(float lo, float hi) { unsigned r; asm volatile("v_cvt_pk_bf16_f32 %0, %1, %2" : "=v"(r) : "v"(lo), "v"(hi)); return r; }
typedef float f32x2 __attribute__((ext_vector_type(2)));
__device__ __forceinline__ f32x2 gelu_pk(f32x2 v) {
    const f32x2 av = __builtin_elementwise_abs(v), d = av * 0.2316418882f + 1.0f;
    f32x2 t; t.x = __builtin_amdgcn_rcpf(d.x); t.y = __builtin_amdgcn_rcpf(d.y);
    f32x2 q = t * 0.5307027145f + (-0.7265760135f); q = q * t + 0.7107068705f; q = q * t + (-0.142248368f); q = q * t + 0.127414796f; q = q * t;
    const f32x2 s = (v * v) * (-0.72134752044f);
    f32x2 e; e.x = __builtin_amdgcn_exp2f(s.x); e.y = __builtin_amdgcn_exp2f(s.y);
    const f32x2 m = v * (q * e), r = v - m;
    f32x2 o; o.x = v.x < 0.f ? m.x : r.x; o.y = v.y < 0.f ? m.y : r.y; return o;
}
constexpr int P_M = 16384, P_SEQ = 4096;
__device__ __forceinline__ f32x4 silu4(f32x4 v) {
    f32x4 o;
#pragma unroll
    for (int i = 0; i < 4; ++i) o[i] = v[i] * __builtin_amdgcn_rcpf(1.0f + __builtin_amdgcn_exp2f(v[i] * -1.4426950408889634f));
    return o;
}
__device__ __forceinline__ f32x4 gelu4(f32x4 v) { const f32x2 a = gelu_pk((f32x2){v[0], v[1]}), b = gelu_pk((f32x2){v[2], v[3]}); return (f32x4){a.x, a.y, b.x, b.y}; }
struct EpiIn {
    static constexpr bool PERM = true, AFTER_DRAIN = false;
    bf16_t* Z; float* STATP; float qscale; unsigned* KN2;
    template <int MODE> __device__ __forceinline__ void store(const f32x4 (&acc)[2][2][4][2], bf16_t* base, int row0, int col0, int sidx) const {
        float kmx[2] = {0.f, 0.f};
#pragma unroll
        for (int ai = 0; ai < 2; ++ai)
#pragma unroll
            for (int m = 0; m < 4; ++m) { bf16_t* rowp = base + (size_t)(row0 + ai * HALF + m * 16) * 1024 + col0; float ssum = 0.f, sq = 0.f;
#pragma unroll
                for (int bj = 0; bj < 2; ++bj) { f32x4 v0 = acc[ai][bj][m][0], v1 = acc[ai][bj][m][1];
                    if (MODE == 1 || MODE == 4) { v0 = gelu4(v0); v1 = gelu4(v1); }
                    if (MODE == 2) { v0 = silu4(v0); v1 = silu4(v1); }
                    if (MODE == 3) { v0 = v0 * qscale; v1 = v1 * qscale; }
                    u32x4 w; w.x = cvt_pk_bf16(v0[0], v0[1]); w.y = cvt_pk_bf16(v0[2], v0[3]); w.z = cvt_pk_bf16(v1[0], v1[1]); w.w = cvt_pk_bf16(v1[2], v1[3]);
                    *(u32x4*)(rowp + bj * HALF) = w;
                    if (MODE == 4) {
#pragma unroll
                        for (int e = 0; e < 4; ++e) { const float lo = __uint_as_float(w[e] << 16), hi = __uint_as_float(w[e] & 0xffff0000u); ssum += lo + hi; sq += lo * lo + hi * hi; } }
                    if (MODE == 5) { float kq = 0.f;
#pragma unroll
                        for (int e = 0; e < 4; ++e) { const float lo = __uint_as_float(w[e] << 16), hi = __uint_as_float(w[e] & 0xffff0000u); kq += lo * lo + hi * hi; }
                        kq += __shfl_xor(kq, 16); kq += __shfl_xor(kq, 32); kmx[bj] = fmaxf(kmx[bj], kq); } }
                if (MODE == 4) { ssum += __shfl_xor(ssum, 16); sq += __shfl_xor(sq, 16); ssum += __shfl_xor(ssum, 32); sq += __shfl_xor(sq, 32);
                    if (sidx >= 0) { float* p = STATP + ((size_t)(row0 + ai * HALF + m * 16) * 16 + sidx) * 2; p[0] = ssum; p[1] = sq; } } }
        if (MODE == 5) {
#pragma unroll
            for (int bj = 0; bj < 2; ++bj) { float v = kmx[bj]; v = fmaxf(v, __shfl_xor(v, 1)); v = fmaxf(v, __shfl_xor(v, 2)); v = fmaxf(v, __shfl_xor(v, 4)); v = fmaxf(v, __shfl_xor(v, 8));
                if ((threadIdx.x & 63) == 0) atomicMax(KN2 + sidx + bj * 4, __float_as_uint(v)); } }
    }
    __device__ __forceinline__ void operator()(const f32x4 (&acc)[2][2][4][2], const Unit& u, int wr, int wc, int fr, int fq) const {
        const int row0 = u.pm * BM + wr * 64 + fr;
        const int t = u.pn >> 2; bf16_t* base = Z + (size_t)t * ((size_t)P_M * 1024); const int col0 = (u.pn & 3) * BM + wc * 32 + 8 * fq;
        if (t == 0) store<1>(acc, base, row0, col0, -1);
        else if (t == 1) store<4>(acc, base, row0, col0, fq == 0 ? (u.pn & 3) * 4 + wc : -1);
        else if (t == 2 || t == 6) store<2>(acc, base, row0, col0, -1);
        else if (t == 3) store<3>(acc, base, row0, col0, -1);
        else if (t == 4) store<5>(acc, base, row0, col0, ((row0 / P_SEQ) * 16 + (u.pn & 3) * 4 + (wc >> 1)) * 2 + (wc & 1));
        else store<0>(acc, base, row0, col0, -1);
    }
};
struct EpiOut {
    static constexpr bool PERM = true, AFTER_DRAIN = false;
    bf16_t* T; const float* gate;
    __device__ __forceinline__ void operator()(const f32x4 (&acc)[2][2][4][2], const Unit& u, int wr, int wc, int fr, int fq) const {
        const int row0 = u.pm * BM + wr * 64 + fr, col0 = u.pn * BM + wc * 32 + 8 * fq; const int b = (u.pm * BM) / P_SEQ;
        f32x4 gv[2][2];
#pragma unroll
        for (int bj = 0; bj < 2; ++bj)
#pragma unroll
            for (int n = 0; n < 2; ++n) gv[bj][n] = *(const f32x4*)(gate + (size_t)b * 6144 + col0 + bj * HALF + 4 * n);
#pragma unroll
        for (int ai = 0; ai < 2; ++ai)
#pragma unroll
            for (int m = 0; m < 4; ++m) { bf16_t* rowp = T + (size_t)(row0 + ai * HALF + m * 16) * 2048 + col0;
#pragma unroll
                for (int bj = 0; bj < 2; ++bj) { const f32x4 v0 = acc[ai][bj][m][0] * gv[bj][0], v1 = acc[ai][bj][m][1] * gv[bj][1];
                    u32x4 w; w.x = cvt_pk_bf16(v0[0], v0[1]); w.y = cvt_pk_bf16(v0[2], v0[3]); w.z = cvt_pk_bf16(v1[0], v1[1]); w.w = cvt_pk_bf16(v1[2], v1[3]);
                    *(u32x4*)(rowp + bj * HALF) = w; } }
    }
};
template <class Epi, class Sched, bool ALIGN_EPI = false, bool SP2 = false>
__device__ __forceinline__ void gemm_phase(PG8_LAS unsigned char* lds, const Gemm g, const Sched& S, const Epi& E, const int tid) {
    const int  wid = __builtin_amdgcn_readfirstlane(tid >> 6), lane = tid & 63, wr = wid >> 2, wc = wid & 3, fr = lane & 15, fq = lane >> 4;
    const int K = g.K, nt = K / BK;
    unsigned voffA[2], voffB[2];
#pragma unroll
    for (int i = 0; i < 2; ++i) { int R, C; stage_rc(tid * 16 + i * 8192, R, C); const int Rb = Epi::PERM ? ((R & ~31) + perm32(R & 31)) : R;
        voffA[i] = (unsigned)(R * K + C) * 2u; voffB[i] = (unsigned)(Rb * K + C) * 2u; }
    const size_t kstep = (size_t)(BK * 2);
    const size_t hstep = (size_t)HALF * K * 2;
    const size_t tstep = 2 * hstep;
    const unsigned ldsw = (unsigned)wid * 1024u;
    const int aoff = lds_byte(wr * 64 + fr, fq * 8), boff = lds_byte(wc * 32 + fr, fq * 8);
#define PG8_SA(b, h) (((b) * 2 + (h)) * HTB)
#define PG8_SB(b, h) ((4 + (b) * 2 + (h)) * HTB)
#define PG8_STAGE(bufoff, gbase, voff) do { _Pragma("unroll") for (int _i = 0; _i < 2; ++_i) \
        __builtin_amdgcn_global_load_lds((const unsigned*)((const char*)(gbase) + (voff)[_i]), (PG8_LAS unsigned*)(lds + (bufoff) + ldsw + _i * 8192), 16, 0, 0); } while (0)
#define PG8_LDA(dst, b, h) do { _Pragma("unroll") for (int m = 0; m < 4; ++m) _Pragma("unroll") for (int k = 0; k < 2; ++k) dst[m][k] = *(const PG8_LAS bf16x8*)(lds + PG8_SA(b, h) + aoff + m * 2048 + k * 1024); } while (0)
#define PG8_LDB(dst, b, h) do { _Pragma("unroll") for (int n = 0; n < 2; ++n) _Pragma("unroll") for (int k = 0; k < 2; ++k) dst[n][k] = *(const PG8_LAS bf16x8*)(lds + PG8_SB(b, h) + boff + n * 2048 + k * 1024); } while (0)
#define PG8_MMA(ai, bj, At, Bt) do { __builtin_amdgcn_s_setprio(1); _Pragma("unroll") for (int m = 0; m < 4; ++m) _Pragma("unroll") for (int n = 0; n < 2; ++n) _Pragma("unroll") for (int k = 0; k < 2; ++k) \
        acc[ai][bj][m][n] = __builtin_amdgcn_mfma_f32_16x16x32_bf16(Bt[n][k], At[m][k], acc[ai][bj][m][n], 0, 0, 0); __builtin_amdgcn_s_setprio(0); } while (0)
#define PG8_WAIT_V(n) asm volatile("s_waitcnt vmcnt(" #n ")" ::: "memory")
#define PG8_WAIT_L(n) asm volatile("s_waitcnt lgkmcnt(" #n ")" ::: "memory")
#define PG8_BAR __builtin_amdgcn_s_barrier()
#define PG8_SCHED __builtin_amdgcn_sched_barrier(0)
    Unit cur, nxt; int ui = 0;
    if (!S.next(0, cur)) return;
    f32x4 acc[2][2][4][2];
#pragma unroll
    for (int a = 0; a < 2; ++a)
#pragma unroll
        for (int b = 0; b < 2; ++b)
#pragma unroll
            for (int m = 0; m < 4; ++m)
#pragma unroll
                for (int n = 0; n < 2; ++n) acc[a][b][m][n] = (f32x4){0.f, 0.f, 0.f, 0.f};
    bf16x8 At[4][2], B0[2][2], B1[2][2];
    const char* cA = (const char*)g.A + (size_t)cur.pm * tstep; const char* cB = (const char*)g.Bt + (size_t)cur.pn * tstep;
    S.a_ready(cur);
    if constexpr (SP2) {
        PG8_STAGE(PG8_SB(0, 0), cB, voffB); PG8_STAGE(PG8_SB(0, 1), cB + hstep, voffB); PG8_STAGE(PG8_SA(0, 0), cA, voffA); PG8_STAGE(PG8_SA(0, 1), cA + hstep, voffA);
        if (wr == 1) PG8_BAR;
        PG8_WAIT_V(2); PG8_BAR;
        PG8_STAGE(PG8_SB(1, 0), cB + kstep, voffB); PG8_STAGE(PG8_SA(1, 0), cA + kstep, voffA); PG8_STAGE(PG8_SB(1, 1), cB + hstep + kstep, voffB);
        PG8_WAIT_V(6); PG8_BAR;
    } else {
        PG8_STAGE(PG8_SB(0, 0), cB, voffB); PG8_STAGE(PG8_SA(0, 0), cA, voffA); PG8_STAGE(PG8_SB(0, 1), cB + hstep, voffB); PG8_STAGE(PG8_SA(0, 1), cA + hstep, voffA);
        if (wr == 1) PG8_BAR;
        PG8_WAIT_V(4); PG8_BAR;
        PG8_STAGE(PG8_SB(1, 0), cB + kstep, voffB); PG8_STAGE(PG8_SA(1, 0), cA + kstep, voffA); PG8_STAGE(PG8_SB(1, 1), cB + hstep + kstep, voffB);
        PG8_WAIT_V(6); PG8_BAR;
    }
    for (;;) {
        const bool has_next = S.next(ui + 1, nxt);
        const char* nA = has_next ? (const char*)g.A + (size_t)nxt.pm * tstep : cA; const char* nB = has_next ? (const char*)g.Bt + (size_t)nxt.pn * tstep : cB;
        for (int t = 0; t < nt; t += 2) {
            const bool last = (t == nt - 2);
            const char* a1 = cA + (size_t)(t + 1) * kstep;
            const char* a2 = last ? nA : cA + (size_t)(t + 2) * kstep; const char* b2 = last ? nB : cB + (size_t)(t + 2) * kstep;
            const char* a3 = a2 + kstep; const char* b3 = b2 + kstep;
            if (last && has_next) S.a_ready(nxt);
            if constexpr (SP2) {
            PG8_LDB(B0, 0, 0); PG8_LDB(B1, 0, 1); PG8_SCHED; PG8_LDA(At, 0, 0); PG8_STAGE(PG8_SA(1, 1), a1 + hstep, voffA);
            PG8_WAIT_V(8); PG8_WAIT_L(0); PG8_BAR; PG8_MMA(0, 0, At, B0); PG8_MMA(0, 1, At, B1); PG8_BAR; PG8_SCHED;
            PG8_LDA(At, 0, 1); PG8_STAGE(PG8_SB(0, 0), b2, voffB); PG8_STAGE(PG8_SB(0, 1), b2 + hstep, voffB); PG8_STAGE(PG8_SA(0, 0), a2, voffA);
            PG8_WAIT_V(8); PG8_WAIT_L(0); PG8_BAR; PG8_MMA(1, 0, At, B0); PG8_MMA(1, 1, At, B1); PG8_BAR; PG8_SCHED;
            PG8_LDB(B0, 1, 0); PG8_LDB(B1, 1, 1); PG8_SCHED; PG8_LDA(At, 1, 0); PG8_STAGE(PG8_SA(0, 1), a2 + hstep, voffA);
            PG8_WAIT_V(8); PG8_WAIT_L(0); PG8_BAR; PG8_MMA(0, 0, At, B0); PG8_MMA(0, 1, At, B1); PG8_BAR; PG8_SCHED;
            PG8_LDA(At, 1, 1); PG8_STAGE(PG8_SB(1, 0), b3, voffB); PG8_STAGE(PG8_SB(1, 1), b3 + hstep, voffB); PG8_STAGE(PG8_SA(1, 0), a3, voffA);
            PG8_WAIT_V(8); PG8_WAIT_L(0); PG8_BAR; PG8_MMA(1, 0, At, B0); PG8_MMA(1, 1, At, B1); PG8_BAR; PG8_SCHED;
            } else {
            PG8_LDB(B0, 0, 0); PG8_SCHED; PG8_LDA(At, 0, 0); PG8_STAGE(PG8_SA(1, 1), a1 + hstep, voffA);
            PG8_WAIT_L(8); PG8_BAR; PG8_WAIT_L(0); PG8_MMA(0, 0, At, B0); PG8_BAR; PG8_SCHED;
            PG8_LDB(B1, 0, 1); PG8_STAGE(PG8_SB(0, 0), b2, voffB);
            PG8_BAR; PG8_WAIT_L(0); PG8_MMA(0, 1, At, B1); PG8_BAR;
            PG8_LDA(At, 0, 1); PG8_STAGE(PG8_SA(0, 0), a2, voffA);
            PG8_BAR; PG8_WAIT_L(0); PG8_MMA(1, 0, At, B0); PG8_BAR; PG8_SCHED;
            PG8_STAGE(PG8_SB(0, 1), b2 + hstep, voffB);
            PG8_WAIT_V(6); PG8_BAR; PG8_MMA(1, 1, At, B1); PG8_BAR;
            PG8_LDB(B0, 1, 0); PG8_SCHED; PG8_LDA(At, 1, 0); PG8_STAGE(PG8_SA(0, 1), a2 + hstep, voffA);
            PG8_WAIT_L(8); PG8_BAR; PG8_WAIT_L(0); PG8_MMA(0, 0, At, B0); PG8_BAR; PG8_SCHED;
            PG8_LDB(B1, 1, 1); PG8_STAGE(PG8_SB(1, 0), b3, voffB);
            PG8_BAR; PG8_WAIT_L(0); PG8_MMA(0, 1, At, B1); PG8_BAR;
            PG8_LDA(At, 1, 1); PG8_STAGE(PG8_SA(1, 0), a3, voffA);
            PG8_BAR; PG8_WAIT_L(0); PG8_MMA(1, 0, At, B0); PG8_BAR; PG8_SCHED;
            PG8_STAGE(PG8_SB(1, 1), b3 + hstep, voffB);
            PG8_WAIT_V(6); PG8_BAR; PG8_MMA(1, 1, At, B1); PG8_BAR;
            }
        }
        if constexpr (ALIGN_EPI) { if (wr == 0) PG8_BAR; }
        if constexpr (!Epi::AFTER_DRAIN) { E(acc, cur, wr, wc, fr, fq); S.done(cur); }
        if (!has_next) break;
#pragma unroll
        for (int a = 0; a < 2; ++a)
#pragma unroll
            for (int b = 0; b < 2; ++b)
#pragma unroll
                for (int m = 0; m < 4; ++m)
#pragma unroll
                    for (int n = 0; n < 2; ++n) acc[a][b][m][n] = (f32x4){0.f, 0.f, 0.f, 0.f};
        cur = nxt; cA = nA; cB = nB; ++ui;
        if constexpr (ALIGN_EPI) { if (wr == 1) PG8_BAR; }
    }
    PG8_WAIT_V(0);
    if constexpr (!ALIGN_EPI) { if (wr == 0) PG8_BAR; }
    PG8_BAR;
    if constexpr (Epi::AFTER_DRAIN) { E.fused(acc, cur, wr, wc, fr, fq, lds, wid, lane); S.done(cur); }
#undef PG8_SA
#undef PG8_SB
#undef PG8_STAGE
#undef PG8_LDA
#undef PG8_LDB
#undef PG8_MMA
#undef PG8_WAIT_V
#undef PG8_WAIT_L
#undef PG8_BAR
#undef PG8_SCHED
}
}
#include <hip/hip_bf16.h>
namespace attn_body {
using bf16=__hip_bfloat16;
using bf16x8=__attribute__((ext_vector_type(8)))short;
using s16x4=__attribute__((ext_vector_type(4)))short;
using f32x16=__attribute__((ext_vector_type(16)))float;
using u32x4=__attribute__((ext_vector_type(4)))unsigned;
constexpr int BATCH=4,NHEAD=16,SEQ=4096,D=64,DM=NHEAD*D,OPITCH=2048;
constexpr int NW=8,QBLK=32,QB=QBLK*NW,KVBLK=64,NQB=SEQ/QB;
constexpr int ATTN_PITCH=DM, ATTN_UNIT_ROWS=QB;
__device__ __forceinline__ int crow(int r,int hi){return (r&3)+8*(r>>2)+4*hi;}
#define SBAR() __builtin_amdgcn_sched_barrier(0)
__device__ __forceinline__ void cmask(f32x16&p0,f32x16&p1,int jb,int qrel,int hi){
  const float NEG=-INFINITY; int kb=64*jb+4*hi;
  #pragma unroll
  for(int r=0;r<16;++r){int kv=kb+(r&3)+8*(r>>2); if(kv>qrel)p0[r]=NEG; if(kv+32>qrel)p1[r]=NEG;}
}

constexpr int NSLOT=3, SLOTB=8192;
constexpr int LDS_K=0, LDS_V=NSLOT*SLOTB, LDS_WS=2*NSLOT*SLOTB, LDS_OST=LDS_WS+NW*64*4, LDS_BYTES=LDS_OST+NW*4096, LDS_NB=LDS_BYTES, LDS_NBW=LDS_NB+SEQ*4, LDS_TOTAL=LDS_NBW+64;
constexpr float C2=0.125f*1.4426950408889634f;
__device__ __forceinline__ void glds16(const void*gsrc,unsigned lds_dst){unsigned keep;
  asm volatile("s_mov_b32 %0, m0\n\ts_mov_b32 m0, %2\n\ts_nop 0\n\tglobal_load_lds_dwordx4 %1, off\n\ts_mov_b32 m0, %0":"=&s"(keep):"v"(gsrc),"s"(lds_dst):"memory");}
__device__ __forceinline__ float max3f(float a,float b,float c){float r;asm("v_max3_f32 %0, %1, %2, %3":"=v"(r):"v"(a),"v"(b),"v"(c));return r;}
__device__ __forceinline__ float max2f(float a,float b){float r;asm("v_max_f32_e32 %0, %1, %2":"=v"(r):"v"(a),"v"(b));return r;}
__device__ __forceinline__ float fadd_s(float a,float b){float r;asm("v_add_f32_e32 %0, %1, %2":"=v"(r):"v"(a),"v"(b));return r;}
__device__ __forceinline__ float fsub_s(float a,float b){float r;asm("v_sub_f32_e32 %0, %1, %2":"=v"(r):"v"(a),"v"(b));return r;}
typedef float f32x2_t __attribute__((ext_vector_type(2))); typedef __bf16 bf16x2_t __attribute__((ext_vector_type(2)));
__device__ __forceinline__ unsigned cvtpk_s(float lo,float hi){f32x2_t v={lo,hi};bf16x2_t b=__builtin_convertvector(v,bf16x2_t);return __builtin_bit_cast(unsigned,b);}
#define WAIT_BAR(N) asm volatile("s_waitcnt vmcnt(" #N ") lgkmcnt(0)\n\ts_barrier":::"memory")

__device__ __forceinline__ void qkt(f32x16&p0,f32x16&p1,const char*Kslot,const bf16x8*qr,int r32,int hi){
  const char*kb=Kslot+hi*1024+r32*16;
  #pragma unroll
  for(int d0=0;d0<4;++d0){
    const bf16x8 b0=*reinterpret_cast<const bf16x8*>(kb+d0*2048);
    const bf16x8 b1=*reinterpret_cast<const bf16x8*>(kb+d0*2048+512);
    p0=__builtin_amdgcn_mfma_f32_32x32x16_bf16(b0,qr[d0],p0,0,0,0);p1=__builtin_amdgcn_mfma_f32_32x32x16_bf16(b1,qr[d0],p1,0,0,0);}
}
typedef __attribute__((address_space(3))) const char* lds_cptr;
typedef short v4i16_t __attribute__((ext_vector_type(4)));
__device__ __forceinline__ void kload8(bf16x8*kf,lds_cptr kp){
  kf[0]=*(const __attribute__((address_space(3))) bf16x8*)(kp);      kf[1]=*(const __attribute__((address_space(3))) bf16x8*)(kp+512);
  kf[2]=*(const __attribute__((address_space(3))) bf16x8*)(kp+2048); kf[3]=*(const __attribute__((address_space(3))) bf16x8*)(kp+2560);
  kf[4]=*(const __attribute__((address_space(3))) bf16x8*)(kp+4096); kf[5]=*(const __attribute__((address_space(3))) bf16x8*)(kp+4608);
  kf[6]=*(const __attribute__((address_space(3))) bf16x8*)(kp+6144); kf[7]=*(const __attribute__((address_space(3))) bf16x8*)(kp+6656);
}
__device__ __forceinline__ void kload2(bf16x8*kf,lds_cptr kp,int j){ kf[2*j]=*(const __attribute__((address_space(3))) bf16x8*)(kp+j*2048); kf[2*j+1]=*(const __attribute__((address_space(3))) bf16x8*)(kp+j*2048+512); }
__device__ __forceinline__ s16x4 vtr(lds_cptr p){ return __builtin_bit_cast(s16x4,__builtin_amdgcn_ds_read_tr16_b64_v4i16((__attribute__((address_space(3))) v4i16_t*)p)); }
__device__ __forceinline__ float rowmax(const f32x16&p0,const f32x16&p1){
  float a=max3f(p0[0],p0[1],p1[0]),b=max3f(p0[2],p0[3],p1[1]);a=max3f(a,p1[2],p1[3]);
  #pragma unroll
  for(int r=4;r<16;r+=4){a=max3f(a,p0[r],p0[r+1]);b=max3f(b,p0[r+2],p0[r+3]);a=max3f(a,p1[r],p1[r+1]);b=max3f(b,p1[r+2],p1[r+3]);}
  const float m=max2f(a,b);
  auto rr=__builtin_amdgcn_permlane32_swap(__float_as_uint(m),__float_as_uint(m),false,false);
  return max2f(__uint_as_float(rr[0]),__uint_as_float(rr[1]));
}
__device__ __forceinline__ void pv(f32x16*o,int vb,bf16x8 pa0,bf16x8 pa1,bf16x8 pa2,bf16x8 pa3){
  #pragma unroll
  for(int d0=0;d0<2;++d0){s16x4 lo[4],hi[4];
    #pragma unroll
    for(int ks=0;ks<4;++ks){
      asm volatile("ds_read_b64_tr_b16 %0,%1 offset:%c2":"=&v"(lo[ks]):"v"(vb),"i"(d0*4096+ks*1024):"memory");
      asm volatile("ds_read_b64_tr_b16 %0,%1 offset:%c2":"=&v"(hi[ks]):"v"(vb),"i"(d0*4096+ks*1024+512):"memory");}
    asm volatile("s_waitcnt lgkmcnt(0)":::"memory");SBAR();
    #define PK(k) (bf16x8){lo[k][0],lo[k][1],lo[k][2],lo[k][3],hi[k][0],hi[k][1],hi[k][2],hi[k][3]}
    o[d0]=__builtin_amdgcn_mfma_f32_32x32x16_bf16(pa0,PK(0),o[d0],0,0,0);
    o[d0]=__builtin_amdgcn_mfma_f32_32x32x16_bf16(pa1,PK(1),o[d0],0,0,0);
    o[d0]=__builtin_amdgcn_mfma_f32_32x32x16_bf16(pa2,PK(2),o[d0],0,0,0);
    o[d0]=__builtin_amdgcn_mfma_f32_32x32x16_bf16(pa3,PK(3),o[d0],0,0,0);
    #undef PK
  }
}

#ifndef ATTN_STORE16
#define ATTN_STORE16(p,v) (*(u32x4*)(p)=(v))
#endif
template<int THRL> __device__ __forceinline__ void attn_unit(int b,int h,int qb,const bf16*Q,const bf16*__restrict__ K,const bf16*__restrict__ V,const bf16*__restrict__ Gt,bf16*O,char*shm,const int tid,const int t0){
  const int lane=tid&63,r32=lane&31,hi=lane>>5; const int wid=__builtin_amdgcn_readfirstlane(tid>>6);
  const long rowbase=(long)b*SEQ; const int q0=qb*QB;
  const bf16*Qw=Q+(rowbase+q0+wid*QBLK)*DM+h*D;
  const bf16*Kh=K+(rowbase+(long)t0*KVBLK)*DM+h*D,*Vh=V+(rowbase+(long)t0*KVBLK)*DM+h*D;
  const unsigned lds0=(unsigned)(uintptr_t)shm;
  float*wsf=(float*)(shm+LDS_WS)+wid*64;
  const bf16*ksrc=Kh+(long)lane*DM+wid*8;
  const bf16*vsrc=Vh+(long)(16*(wid&3)+(lane>>2))*DM+(wid>>2)*32+(lane&3)*8;
  const unsigned kdst=lds0+LDS_K+wid*1024, vdst=lds0+LDS_V+wid*1024;
  #define DMA_K(t,slot) glds16(ksrc+(long)(t)*KVBLK*DM,(unsigned)__builtin_amdgcn_readfirstlane(kdst+(slot)))
  #define DMA_V(t,slot) glds16(vsrc+(long)(t)*KVBLK*DM,(unsigned)__builtin_amdgcn_readfirstlane(vdst+(slot)))
  const int vb0=(int)(lds0+LDS_V)+((lane>>4)&1)*32+(lane&3)*8+(4*hi+((lane&15)>>2))*64;
  const char*Kbase=shm+LDS_K; bf16x8 kf[8];
  const lds_cptr shm3=(lds_cptr)shm; const lds_cptr kp0=shm3+LDS_K+hi*1024+r32*16; const lds_cptr vp0=shm3+LDS_V+((lane>>4)&1)*32+(lane&3)*8+(4*hi+((lane&15)>>2))*64;
  const int NT=(q0+QB)/KVBLK-t0;
  DMA_K(0,0);DMA_V(0,0);DMA_K(1,SLOTB);
  bf16x8 qr[4];
  #pragma unroll
  for(int d0=0;d0<4;++d0)qr[d0]=*reinterpret_cast<const bf16x8*>(&Qw[(long)r32*DM+d0*16+hi*8]);
  float mhat=0.f,l_reg=0.f;f32x16 o[2];o[0]=f32x16{};o[1]=f32x16{};
  typedef __attribute__((address_space(3))) const float* lds_fptr; typedef float f32x4_t __attribute__((ext_vector_type(4)));
  const lds_fptr nbp0=(lds_fptr)(shm3+LDS_NB)+4*hi+t0*KVBLK;
  #define NBLOAD(C0,C1,t) do{ const lds_fptr nbp_=nbp0+(t)*KVBLK; \
    _Pragma("unroll") for(int g_=0;g_<4;++g_){ const f32x4_t a_=*(const __attribute__((address_space(3))) f32x4_t*)(nbp_+8*g_); const f32x4_t b_=*(const __attribute__((address_space(3))) f32x4_t*)(nbp_+32+8*g_); \
      C0[4*g_]=a_[0];C0[4*g_+1]=a_[1];C0[4*g_+2]=a_[2];C0[4*g_+3]=a_[3]; C1[4*g_]=b_[0];C1[4*g_+1]=b_[1];C1[4*g_+2]=b_[2];C1[4*g_+3]=b_[3]; } }while(0)
  #define CINIT(C0,C1,t) do{ const lds_fptr nbp_=nbp0+(t)*KVBLK; const float nm_=-mhat; \
    _Pragma("unroll") for(int g_=0;g_<4;++g_){ const f32x4_t a_=*(const __attribute__((address_space(3))) f32x4_t*)(nbp_+8*g_); const f32x4_t b_=*(const __attribute__((address_space(3))) f32x4_t*)(nbp_+32+8*g_); \
      C0[4*g_]=a_[0]+nm_;C0[4*g_+1]=a_[1]+nm_;C0[4*g_+2]=a_[2]+nm_;C0[4*g_+3]=a_[3]+nm_; C1[4*g_]=b_[0]+nm_;C1[4*g_+1]=b_[1]+nm_;C1[4*g_+2]=b_[2]+nm_;C1[4*g_+3]=b_[3]+nm_; } }while(0)
  const int qrel=wid*QBLK+r32;
  #define CMASK(P0,P1,t) do{int jb_=(t)-(NT-4); if(jb_>=0)cmask(P0,P1,jb_,qrel,hi);}while(0)
  bool resc=false;
  #define START(P0,P1) do{ const float rm=rowmax(P0,P1); resc=false; \
    { const float dl=rm; mhat=fadd_s(mhat,dl); \
      _Pragma("unroll") for(int r=0;r<16;++r){P0[r]=fsub_s(P0[r],dl);P1[r]=fsub_s(P1[r],dl);} } \
    _Pragma("unroll") for(int r=0;r<16;++r)P0[r]=__builtin_amdgcn_exp2f(P0[r]); }while(0)
  #define RESC() do{ if(resc){ asm volatile("s_waitcnt lgkmcnt(0)":::"memory"); \
      _Pragma("unroll") for(int d_=0;d_<2;++d_) _Pragma("unroll") for(int r=0;r<16;++r)o[d_][r]*=wsf[crow(r,hi)]; } }while(0)
  f32x16 pA0,pA1,pB0,pB1;
  int sl_prev=0,sl_cur=0,sl_next=SLOTB;
  #define ROT() do{sl_prev=sl_cur;sl_cur=sl_next;sl_next=(sl_next==(NSLOT-1)*SLOTB)?0:sl_next+SLOTB;}while(0)
  DMA_K(2,2*SLOTB);
  WAIT_BAR(3);
  CINIT(pA0,pA1,0); qkt(pA0,pA1,Kbase,qr,r32,hi);asm volatile("s_nop 15\n\ts_nop 7":"+v"(pA0),"+v"(pA1));CMASK(pA0,pA1,0);
  START(pA0,pA1);
  CINIT(pB0,pB1,1);
  _Pragma("unroll") for(int r=0;r<16;++r)pA1[r]=__builtin_amdgcn_exp2f(pA1[r]);
  WAIT_BAR(0);
  DMA_K(3,0);DMA_V(1,SLOTB);
  ROT();
  kload8(kf,kp0+sl_cur);
  WAIT_BAR(2);
  s16x4 vlo[8],vhi[8]; u32x4 pw0,pw1,pw2,pw3;
  #define PKW(P,B) cvtpk_s(P[B],P[B+1])
  #define PAF(k) __builtin_bit_cast(bf16x8,pw##k)
  #define VFR(i) (bf16x8){vlo[i][0],vlo[i][1],vlo[i][2],vlo[i][3],vhi[i][0],vhi[i][1],vhi[i][2],vhi[i][3]}
  #define PIN(x) asm volatile("":"+v"(x))
  #define MX3(a,b,c) __builtin_fmaxf(__builtin_fmaxf((a),(b)),(c))
  #define GAPA(MF,A0,A1,A2,A3,W0,W1,PW) do{ MF; sacc+=A0; sacc+=A1; sacc+=A2; sacc+=A3; PIN(sacc); W0; W1; PIN(PW); SBAR(); }while(0)
  #define EX(v) __builtin_amdgcn_exp2f(v)
  #define GAPB(MF,X,B,Y) do{ MF; X[B]=EX(X[B]); X[B+1]=EX(X[B+1]); X[B+2]=EX(X[B+2]); X[B+3]=EX(X[B+3]); Y[B]+=nmn_; Y[B+1]+=nmn_; Y[B+2]+=nmn_; Y[B+3]+=nmn_; PIN(X); PIN(Y); SBAR(); }while(0)
  #define VRD(i) do{ vlo[i]=vtr(vp_+(((i)>>2)*4096+((i)&3)*1024)); vhi[i]=vtr(vp_+(((i)>>2)*4096+((i)&3)*1024+512)); }while(0)
  #define KRD(G,j) do{ if(G){ kload2(kf,kp0+sl_next,j); SBAR(); } }while(0)
  #define STEP(C0,C1,P0,P1,t,GK,GV,GL) do{ SBAR(); \
    const lds_cptr vp_=vp0+sl_prev; \
    VRD(0); SBAR(); float sacc=(P0[0]+P0[1]); \
    GAPA(C0=__builtin_amdgcn_mfma_f32_32x32x16_bf16(kf[0],qr[0],C0,0,0,0), P0[2],P0[3],P0[4],P0[5],     pw0[0]=PKW(P0,0), pw0[1]=PKW(P0,2), pw0); \
    VRD(4); SBAR(); GAPA(C1=__builtin_amdgcn_mfma_f32_32x32x16_bf16(kf[1],qr[0],C1,0,0,0), P0[6],P0[7],P0[8],P0[9],     pw0[2]=PKW(P0,4), pw0[3]=PKW(P0,6), pw0); \
    VRD(1); SBAR(); GAPA(C0=__builtin_amdgcn_mfma_f32_32x32x16_bf16(kf[2],qr[1],C0,0,0,0),   P0[10],P0[11],P0[12],P0[13], pw1[0]=PKW(P0,8), pw1[1]=PKW(P0,10), pw1); \
    VRD(5); SBAR(); GAPA(C1=__builtin_amdgcn_mfma_f32_32x32x16_bf16(kf[3],qr[1],C1,0,0,0),   P0[14],P0[15],P1[0],P1[1],   pw1[2]=PKW(P0,12),pw1[3]=PKW(P0,14), pw1); \
    VRD(2); SBAR(); GAPA(C0=__builtin_amdgcn_mfma_f32_32x32x16_bf16(kf[4],qr[2],C0,0,0,0),   P1[2],P1[3],P1[4],P1[5],     pw2[0]=PKW(P1,0), pw2[1]=PKW(P1,2), pw2); \
    VRD(6); SBAR(); GAPA(C1=__builtin_amdgcn_mfma_f32_32x32x16_bf16(kf[5],qr[2],C1,0,0,0),   P1[6],P1[7],P1[8],P1[9],     pw2[2]=PKW(P1,4), pw2[3]=PKW(P1,6), pw2); \
    VRD(3); SBAR(); GAPA(C0=__builtin_amdgcn_mfma_f32_32x32x16_bf16(kf[6],qr[3],C0,0,0,0),   P1[10],P1[11],P1[12],P1[13], pw3[0]=PKW(P1,8), pw3[1]=PKW(P1,10), pw3); \
    VRD(7); SBAR(); GAPA(C1=__builtin_amdgcn_mfma_f32_32x32x16_bf16(kf[7],qr[3],C1,0,0,0),   P1[14],P1[15],0.f,0.f,       pw3[2]=PKW(P1,12),pw3[3]=PKW(P1,14), pw3); \
    l_reg+=sacc; \
    if(GK){DMA_K((t)+3,sl_cur);} if(GV){DMA_V((t)+1,sl_next);} \
    CMASK(C0,C1,t); \
    { float a=MX3(C0[0],C0[1],C1[0]),b=MX3(C0[2],C0[3],C1[1]); a=MX3(a,C1[2],C1[3]); \
      _Pragma("unroll") for(int r=4;r<16;r+=4){a=MX3(a,C0[r],C0[r+1]);b=MX3(b,C0[r+2],C0[r+3]);a=MX3(a,C1[r],C1[r+1]);b=MX3(b,C1[r+2],C1[r+3]);} \
      float rm=__builtin_fmaxf(a,b); { auto rr=__builtin_amdgcn_permlane32_swap(__float_as_uint(rm),__float_as_uint(rm),false,false); rm=__builtin_fmaxf(__uint_as_float(rr[0]),__uint_as_float(rr[1])); } \
      resc=false; \
      if(__builtin_expect(__any(rm>(float)THRL),0)){ const float dl=__builtin_fmaxf(rm,0.f); mhat+=dl; \
        _Pragma("unroll") for(int r=0;r<16;++r){C0[r]-=dl;C1[r]-=dl;} \
        const float f=__builtin_amdgcn_exp2f(-dl); l_reg*=f; if(hi==0)wsf[r32]=f; resc=true; } } \
    const float nmn_=-mhat; if(GL){ NBLOAD(P0,P1,(t)+1); } \
    SBAR(); \
    GAPB(o[0]=__builtin_amdgcn_mfma_f32_32x32x16_bf16(PAF(0),VFR(0),o[0],0,0,0), C0,0,P0); \
    GAPB(o[1]=__builtin_amdgcn_mfma_f32_32x32x16_bf16(PAF(0),VFR(4),o[1],0,0,0), C0,4,P0); \
    KRD(GL,0); GAPB(o[0]=__builtin_amdgcn_mfma_f32_32x32x16_bf16(PAF(1),VFR(1),o[0],0,0,0), C0,8,P0); \
    KRD(GL,1); GAPB(o[1]=__builtin_amdgcn_mfma_f32_32x32x16_bf16(PAF(1),VFR(5),o[1],0,0,0), C0,12,P0); \
    KRD(GL,2); GAPB(o[0]=__builtin_amdgcn_mfma_f32_32x32x16_bf16(PAF(2),VFR(2),o[0],0,0,0), C1,0,P1); \
    KRD(GL,3); GAPB(o[1]=__builtin_amdgcn_mfma_f32_32x32x16_bf16(PAF(2),VFR(6),o[1],0,0,0), C1,4,P1); \
    GAPB(o[0]=__builtin_amdgcn_mfma_f32_32x32x16_bf16(PAF(3),VFR(3),o[0],0,0,0), C1,8,P1); \
    GAPB(o[1]=__builtin_amdgcn_mfma_f32_32x32x16_bf16(PAF(3),VFR(7),o[1],0,0,0), C1,12,P1); \
    }while(0)
  int t=1;
  #undef CMASK
  #define CMASK(P0,P1,t) do{}while(0)
  for(;t+5<NT;t+=2){
    STEP(pB0,pB1,pA0,pA1,t,true,true,true);     WAIT_BAR(2); RESC(); ROT();
    STEP(pA0,pA1,pB0,pB1,t+1,true,true,true);   WAIT_BAR(2); RESC(); ROT();
  }
  #undef CMASK
  #define CMASK(P0,P1,t) do{int jb_=(t)-(NT-4); if(jb_>=0)cmask(P0,P1,jb_,qrel,hi);}while(0)
  #define ENDW(tt) do{ if((tt)+3<NT){WAIT_BAR(2);} else if((tt)+2<NT){WAIT_BAR(1);} else {WAIT_BAR(0);} }while(0)
  for(;t+1<NT;t+=2){
    STEP(pB0,pB1,pA0,pA1,t,(t+3<NT),(t+1<NT),(t+1<NT));       ENDW(t);   RESC(); ROT();
    STEP(pA0,pA1,pB0,pB1,t+1,(t+4<NT),(t+2<NT),(t+2<NT));     ENDW(t+1); RESC(); ROT();
  }
  STEP(pB0,pB1,pA0,pA1,NT-1,false,false,false); RESC();
  { float sacc=pB0[0]+pB0[1]; _Pragma("unroll") for(int r=2;r<16;++r)sacc+=pB0[r]; _Pragma("unroll") for(int r=0;r<16;++r)sacc+=pB1[r]; l_reg+=sacc;
    pw0=(u32x4){PKW(pB0,0),PKW(pB0,2),PKW(pB0,4),PKW(pB0,6)};pw1=(u32x4){PKW(pB0,8),PKW(pB0,10),PKW(pB0,12),PKW(pB0,14)};pw2=(u32x4){PKW(pB1,0),PKW(pB1,2),PKW(pB1,4),PKW(pB1,6)};pw3=(u32x4){PKW(pB1,8),PKW(pB1,10),PKW(pB1,12),PKW(pB1,14)};
    SBAR(); pv(o,vb0+sl_cur,PAF(0),PAF(1),PAF(2),PAF(3)); }
  #undef PKW
  #undef PAF
  #undef VFR
  #undef PIN
  #undef MX3
  #undef GAPA
  #undef GAPB
  #undef EX
  #undef VRD
  #undef KRD
  #undef STEP
  #undef ENDW
  {auto rr=__builtin_amdgcn_permlane32_swap(__float_as_uint(l_reg),__float_as_uint(l_reg),false,false);l_reg=__uint_as_float(rr[0])+__uint_as_float(rr[1]);}
  if(hi==0)wsf[32+r32]=l_reg;asm volatile("s_waitcnt lgkmcnt(0)":::"memory");
  float rli[16];
  #pragma unroll
  for(int r=0;r<16;++r)rli[r]=__builtin_amdgcn_rcpf(wsf[32+crow(r,hi)]);
  bf16*Ow=O+(rowbase+q0+wid*QBLK)*OPITCH+h*D; const bf16*Gw=Gt+(rowbase+q0+wid*QBLK)*DM+h*D;
  { bf16*stg=(bf16*)(shm+LDS_OST)+wid*2048;
    #pragma unroll
    for(int r=0;r<16;++r){const int orow=crow(r,hi);
      #pragma unroll
      for(int d0=0;d0<2;++d0)stg[orow*64+d0*32+r32]=__float2bfloat16(o[d0][r]*rli[r]);}
    asm volatile("s_waitcnt lgkmcnt(0)":::"memory");
    #pragma unroll
    for(int i=0;i<4;++i){const int row=i*8+(lane>>3),ch=lane&7; const u32x4 v=*(const u32x4*)(stg+row*64+ch*8); const u32x4 gv=*(const u32x4*)(Gw+(long)row*DM+ch*8); u32x4 w;
      #pragma unroll
      for(int e=0;e<4;++e){ const float lo=__uint_as_float(v[e]<<16)*__uint_as_float(gv[e]<<16), hh=__uint_as_float(v[e]&0xffff0000u)*__uint_as_float(gv[e]&0xffff0000u); w[e]=cvtpk_s(lo,hh); }
      ATTN_STORE16(Ow+(long)row*OPITCH+ch*8,w);} }
  asm volatile("s_waitcnt lgkmcnt(0)\n\ts_barrier":::"memory");
  #undef DMA_K
  #undef DMA_V
  #undef CMASK
  #undef START
  #undef RESC
  #undef CINIT
  #undef NBLOAD
  #undef ROT
}
constexpr int ATTN_LDS_BYTES=LDS_TOTAL;
struct AttnTensors { const bf16* Q; long strideZ; long offO; long offNB; };
struct AttnUnit { int bh; int qb; };
struct StaticOrder {
  int vcu;
  __device__ __forceinline__ explicit StaticOrder(int grid,int block):vcu((grid%8==0)?(block%8)*(grid/8)+block/8:block){}
  __device__ __forceinline__ bool next(int i,AttnUnit&u)const{ if(i>=4)return false; const int s=vcu&3; u.bh=vcu>>2; u.qb=(i==0)?15-s:(i==1)?8+s:(i==2)?7-s:s; return true; }
};
template<int THRL=8> __device__ __forceinline__ void attn_phase(char*lds,const AttnTensors&T,int grid,int block,const int tid,unsigned*qctr,const unsigned*kn2){
  const int vc0=((grid%8==0)?(block%8)*(grid/8)+block/8:block); const int wid=tid>>6, lane=tid&63;
  float*wt=(float*)(lds+LDS_NBW);
  int u=vc0;
  while(u<BATCH*NHEAD*16){
    const int qb=15-(u>>6), bh=u&63, b=bh>>4, h=bh&15;
    int tid_u=tid; asm volatile("":"+v"(tid_u));
    { const float4*src=(const float4*)((const float*)((const char*)T.Q+T.offNB)+(size_t)bh*SEQ); float4*dst=(float4*)(lds+LDS_NB); const int n4=(qb+1)*(QB/4);
      unsigned pulled=0u; if(tid_u==0)pulled=atomicAdd(qctr,1u);
      const int x0=tid_u,x1=tid_u+NW*64; float4 nba=make_float4(0.f,0.f,0.f,0.f),nbb=nba; if(x0<n4)nba=src[x0]; if(x1<n4)nbb=src[x1];
      const bf16*Qw=T.Q+((long)b*SEQ+qb*QB+wid*QBLK+(lane&31))*DM+h*D+(lane>>5)*8; float sq=0.f;
      #pragma unroll
      for(int d0=0;d0<4;++d0){ const u32x4 v=*(const u32x4*)(Qw+d0*16);
        #pragma unroll
        for(int e=0;e<4;++e){ const float lo=__uint_as_float(v[e]<<16),hi2=__uint_as_float(v[e]&0xffff0000u); sq+=lo*lo+hi2*hi2; } }
      sq+=__shfl_xor(sq,32);
      #pragma unroll
      for(int o=1;o<32;o<<=1)sq=fmaxf(sq,__shfl_xor(sq,o));
      if(x0<n4)dst[x0]=nba; if(x1<n4)dst[x1]=nbb;
      if(lane==0)wt[wid]=sq;
      if(tid_u==0)wt[8]=__uint_as_float((unsigned)grid+pulled);
      __syncthreads(); }
    const int NTF=4*qb+4; int t0;
    { float q2=wt[0];
      #pragma unroll
      for(int w=1;w<8;++w)q2=fmaxf(q2,wt[w]);
      const float k2=__uint_as_float(kn2[bh*2])+__uint_as_float(kn2[bh*2+1]);
      const float TH=64.f+2.f*sqrtf(q2*k2)*1.001f;
      const float*nbl=(const float*)(lds+LDS_NB); const float nbq=nbl[qb*QB];
      const bool skip=(lane<NTF)&&(nbq-nbl[64*(lane<NTF?lane:0)+63]>TH);
      const unsigned long long m=__ballot(skip); const int ns=(~m==0ull)?64:__builtin_ctzll(~m);
      t0=ns&~1; if(t0>NTF-4)t0=NTF-4; t0=__builtin_amdgcn_readfirstlane(t0); }
    const int unext=(int)__float_as_uint(wt[8]);
    attn_unit<THRL>(b,h,qb,T.Q,T.Q+T.strideZ,T.Q+2*T.strideZ,T.Q+3*T.strideZ,(bf16*)((char*)T.Q+T.offO),lds,tid_u,t0);
    u=__builtin_amdgcn_readfirstlane(unext);
  }
}
#undef SBAR
#undef WAIT_BAR
}
constexpr int NB = 4, SEQ = 4096, DM = 2048, DEPTH = 2, M = NB * SEQ, DIN = 7184, NPAD = 7168, WA = 1024;
constexpr int NWAVES = 8, NTHR = 512;
constexpr float EPS = 1e-6f;
constexpr size_t MiB = 1u << 20;
constexpr size_t WS_MODP = 2 * MiB;
constexpr size_t WS_WS = 6 * MiB;
constexpr size_t WS_MODF = 5 * MiB;
constexpr size_t WS_LF = 7 * MiB;
constexpr size_t WS_WIN = 8 * MiB;
constexpr size_t WS_WOUT = 66 * MiB;
constexpr size_t WS_H = 82 * MiB;
constexpr size_t WS_Z = 146 * MiB;
constexpr size_t WS_Y = 370 * MiB;
constexpr size_t WS_STATP = 434 * MiB;
constexpr size_t WS_NB = 436 * MiB;
constexpr size_t WS_T0 = 438 * MiB;
constexpr size_t WS_END = 502 * MiB;
constexpr int MOD_KC = 16, MOD_KROWS = 128;
constexpr int LDS_PHASE = 147456, LDS_BYTES = LDS_PHASE + 256;
constexpr size_t WS_BAR = 0, BAR_ZERO_BYTES = 16384, WS_KN2 = 14336  , WS_QCTR = 15360  , WS_MCTR = 15424  , WS_TCTR = 15616  ;

#define LAS __attribute__((address_space(3)))
typedef unsigned short bf16;
typedef unsigned v4u __attribute__((ext_vector_type(4)));
typedef unsigned v2u __attribute__((ext_vector_type(2)));
typedef float f32x4 __attribute__((ext_vector_type(4)));
typedef float f32x16 __attribute__((ext_vector_type(16)));
typedef short bf16x8 __attribute__((ext_vector_type(8)));
__device__ __forceinline__ unsigned pk2(float lo, float hi) { typedef float f2 __attribute__((ext_vector_type(2))); typedef __bf16 b2 __attribute__((ext_vector_type(2))); f2 v = {lo, hi}; b2 b = __builtin_convertvector(v, b2); return __builtin_bit_cast(unsigned, b); }
typedef _Float16 h16x2 __attribute__((ext_vector_type(2))); typedef float f32x2h __attribute__((ext_vector_type(2)));
__device__ __forceinline__ unsigned pkh2(float lo, float hi) { f32x2h v = {lo, hi}; h16x2 h = __builtin_convertvector(v, h16x2); return __builtin_bit_cast(unsigned, h); }
__device__ __forceinline__ f32x2h uph2(unsigned u) { return __builtin_convertvector(__builtin_bit_cast(h16x2, u), f32x2h); }
__device__ __forceinline__ float bflo(unsigned u) { return __uint_as_float(u << 16); }
__device__ __forceinline__ float bfhi(unsigned u) { return __uint_as_float(u & 0xffff0000u); }
__device__ __forceinline__ float wave_sum(float v) {
#pragma unroll
    for (int o = 1; o < 64; o <<= 1) v += __shfl_xor(v, o);
    return v;
}

#define XB_TMO      128
#define XB_XCNT(j)  (256  + 64 * (j))
#define XB_XSUB(j)  (1280 + 64 * (j))
#define XB_XGEN(j)  (2304 + 64 * (j))
#define XB_TOP      3328
#define XB_TOPGEN   3392
#define XCD_BAR_WORDS 3456
#define XB_SPIN_CAP (1u << 18)

__device__ __forceinline__ unsigned xb_ld(unsigned* p)              { return __hip_atomic_load(p, __ATOMIC_RELAXED, __HIP_MEMORY_SCOPE_AGENT); }
__device__ __forceinline__ unsigned xb_add(unsigned* p, unsigned v) { return __hip_atomic_fetch_add(p, v, __ATOMIC_RELAXED, __HIP_MEMORY_SCOPE_AGENT); }
__device__ __forceinline__ unsigned xb_xcc_id() { return (unsigned)__builtin_amdgcn_s_getreg((3 << 11) | 20) & 0xFu; }
#define XB_SPIN(cond, bar) do { unsigned _sp = 0; while (cond) { __builtin_amdgcn_s_sleep(1); \
    if ((++_sp & 255u) == 0u) { if (xb_ld(&(bar)[XB_TMO])) break; if (_sp > XB_SPIN_CAP) { atomicAdd(&(bar)[XB_TMO], 1u); break; } } } } while (0)

struct XcdBarrier {
    unsigned* bar; unsigned x;
    volatile LAS unsigned* st;
};

__device__ __forceinline__ XcdBarrier xcd_barrier_post(unsigned* bar, volatile LAS unsigned* st) {
    XcdBarrier b; b.bar = bar; b.x = xb_xcc_id(); b.st = st;
    if (threadIdx.x == 0) (void)xb_add(&bar[XB_XCNT(b.x)], 1u);
    return b;
}
__device__ __forceinline__ void xcd_barrier_complete(unsigned* bar, unsigned x, unsigned& nloc, unsigned& nx) {
    const unsigned G = gridDim.x * gridDim.y * gridDim.z;
    unsigned sum, cnt, mine, sp = 0u;
    for (;;) {
        sum = 0u; cnt = 0u; mine = 0u;
#pragma unroll
        for (unsigned j = 0; j < 16; ++j) { const unsigned c = xb_ld(&bar[XB_XCNT(j)]); sum += c; cnt += (c > 0u) ? 1u : 0u; mine = (j == x) ? c : mine; }
        if (sum == G) break;
        __builtin_amdgcn_s_sleep(1);
        if ((++sp & 255u) == 0u) { if (xb_ld(&bar[XB_TMO])) break; if (sp > XB_SPIN_CAP) { atomicAdd(&bar[XB_TMO], 1u); break; } }
    }
    nloc = mine > 0u ? mine : 1u; nx = cnt > 0u ? cnt : 1u;
}

__device__ __forceinline__ void xcd_barrier(const XcdBarrier& b) {
    asm volatile("s_waitcnt vmcnt(0)" ::: "memory");
    __syncthreads();
    if (threadIdx.x == 0) {
        unsigned* bar = b.bar;
        __builtin_amdgcn_s_waitcnt(0);
        unsigned nloc = b.st[0], nx = b.st[1];
        if (nloc == 0u) { xcd_barrier_complete(bar, b.x, nloc, nx); b.st[0] = nloc; b.st[1] = nx; }
        const unsigned old = xb_add(&bar[XB_XSUB(b.x)], 1u);
        const unsigned gen = old / nloc;
        if (old + 1u == (gen + 1u) * nloc) {
            __builtin_amdgcn_fence(__ATOMIC_RELEASE, "agent");
            asm volatile("s_waitcnt vmcnt(0)" ::: "memory");
            const unsigned og = xb_add(&bar[XB_TOP], 1u);
            const unsigned tg = og / nx;
            if (og + 1u == (tg + 1u) * nx) xb_add(&bar[XB_TOPGEN], 1u);
            else XB_SPIN(xb_ld(&bar[XB_TOPGEN]) == tg, bar);
            __builtin_amdgcn_fence(__ATOMIC_ACQUIRE, "agent");
            xb_add(&bar[XB_XGEN(b.x)], 1u);
            asm volatile("s_waitcnt vmcnt(0)" ::: "memory");
        } else {
            XB_SPIN(xb_ld(&bar[XB_XGEN(b.x)]) == gen, bar);
            __builtin_amdgcn_fence(__ATOMIC_ACQUIRE, "agent");
            asm volatile("s_waitcnt vmcnt(0)" ::: "memory");
        }
    }
    __syncthreads();
}

struct Args { const float* in[13]; float* out; unsigned char* ws; int ph_lo, ph_hi; };

__device__ __forceinline__ void p0_transpose_item(const float* W, int K, int N, int ldw, bf16* WT, LAS float* scr, int item, int lane) {
    const int nblk = N / 32, kb = item / nblk, nb = item % nblk, k0 = 64 * kb, n0 = 32 * nb;
    f32x4 tv[8];
#pragma unroll
    for (int i = 0; i < 8; ++i) tv[i] = __builtin_nontemporal_load((const f32x4*)(W + (size_t)(k0 + 8 * i + (lane >> 3)) * ldw + n0 + 4 * (lane & 7)));
#pragma unroll
    for (int i = 0; i < 8; ++i) { LAS float* d = scr + (8 * i + (lane >> 3)) * 33 + 4 * (lane & 7); d[0] = tv[i][0]; d[1] = tv[i][1]; d[2] = tv[i][2]; d[3] = tv[i][3]; }
    asm volatile("s_waitcnt lgkmcnt(0)" ::: "memory");
    const int c = lane & 7;
#pragma unroll
    for (int j = 0; j < 4; ++j) { const int n = (lane >> 3) + 8 * j; const LAS float* s = scr + (8 * c) * 33 + n;
        v4u o; o.x = pk2(s[0 * 33], s[1 * 33]); o.y = pk2(s[2 * 33], s[3 * 33]); o.z = pk2(s[4 * 33], s[5 * 33]); o.w = pk2(s[6 * 33], s[7 * 33]);
        *(v4u*)(WT + (size_t)(n0 + n) * K + k0 + 8 * c) = o; }
    asm volatile("s_waitcnt lgkmcnt(0)" ::: "memory");
}
__device__ __forceinline__ void p0_mod_item(const float* cin, const float* w_ada, const float* b_ada, float* modp, float* modf, unsigned* mctr, int idx, int lane) {
    const int l = idx / (24 * MOD_KC), r = idx % (24 * MOD_KC), cgp = r / MOD_KC, kc = r % MOD_KC;
    const float* W = w_ada + (size_t)l * DM * 6144 + (size_t)(kc * MOD_KROWS) * 6144 + cgp * 256 + lane * 4;
    f32x4 acc[4];
#pragma unroll
    for (int b = 0; b < 4; ++b) acc[b] = (f32x4){0.f, 0.f, 0.f, 0.f};
#pragma unroll
    for (int j = 0; j < MOD_KROWS / 64; ++j) {
        float sv[4];
#pragma unroll
        for (int b = 0; b < 4; ++b) { const float c = cin[b * DM + kc * MOD_KROWS + j * 64 + lane]; sv[b] = c / (1.0f + __expf(-c)); }
#pragma unroll 16
        for (int kk = 0; kk < 64; ++kk) { const f32x4 w = __builtin_nontemporal_load((const f32x4*)(W + (size_t)(j * 64 + kk) * 6144));
#pragma unroll
            for (int b = 0; b < 4; ++b) { const float s = __uint_as_float(__builtin_amdgcn_readlane(__float_as_uint(sv[b]), kk)); acc[b] += w * s; } }
    }
#pragma unroll
    for (int b = 0; b < 4; ++b) *(f32x4*)(modp + (((size_t)kc * 2 + l) * 4 + b) * 6144 + cgp * 256 + lane * 4) = acc[b];
}
__device__ __forceinline__ void p0_prologue(const Args& a, LAS unsigned char* lds, int vcu, int G, int wave, int lane, bool dup) {
    LAS float* scr = (LAS float*)(lds + wave * 16384);
    unsigned char* ws = a.ws;
    constexpr int I_MOD = 2 * 24 * MOD_KC, I_IN = (DM / 64) * (NPAD / 32), I_OUT = (DM / 64) * (DM / 32), I_WS = (2 * 8 * 128 * 128) / 512;
    constexpr int NCONV = 2 * I_IN + 2 * I_OUT + I_WS;
    if (wave == 0 && lane == 0) *(LAS unsigned*)(lds + 131072) = 0u;
    __syncthreads();
    if (!(dup && PROBE_PART == 2)) for (int m = vcu + G * wave; m < I_MOD; m += G * NWAVES) p0_mod_item(a.in[1], a.in[3], a.in[4], (float*)(ws + WS_MODP), (float*)(ws + WS_MODF), (unsigned*)(ws + WS_MCTR), m, lane);
    LAS unsigned* lctr = (LAS unsigned*)(lds + 131072);
    if (!(dup && PROBE_PART == 1)) for (;;) {
        unsigned itu = 0u; if (lane == 0) itu = __hip_atomic_fetch_add(lctr, 1u, __ATOMIC_RELAXED, __HIP_MEMORY_SCOPE_WORKGROUP);
        int r = vcu + G * __builtin_amdgcn_readfirstlane((int)itu);
        if (r >= NCONV) break;
        if (r < 2 * I_IN) { const int l = r / I_IN; p0_transpose_item(a.in[5] + (size_t)l * DM * DIN, DM, NPAD, DIN, (bf16*)(ws + WS_WIN) + (size_t)l * NPAD * DM, scr, r % I_IN, lane); continue; } r -= 2 * I_IN;
        if (r < 2 * I_OUT) { const int l = r / I_OUT; p0_transpose_item(a.in[11] + (size_t)l * DM * DM, DM, DM, DM, (bf16*)(ws + WS_WOUT) + (size_t)l * DM * DM, scr, r % I_OUT, lane); continue; } r -= 2 * I_OUT;
        { const float* src = a.in[8] + (size_t)r * 512 + lane * 8; const f32x4 x0 = *(const f32x4*)src, x1 = *(const f32x4*)(src + 4);
          v4u o; o.x = pk2(x0[0], x0[1]); o.y = pk2(x0[2], x0[3]); o.z = pk2(x1[0], x1[1]); o.w = pk2(x1[2], x1[3]);
          *(v4u*)((bf16*)(ws + WS_WS) + (size_t)r * 512 + lane * 8) = o; }
    }
}
__device__ __forceinline__ void p1_modnorm(const Args& a, LAS unsigned char* lds, int l, const float* xin, const bf16* T0, int bid, int G, int tid, int wave, int lane) {
    LAS float* gs = (LAS float*)lds; LAS float* sh = gs + DM;
    LAS unsigned char* WfT = lds + 16384; LAS unsigned char* hT = lds + 81920 + wave * 8192;
    const float* modf = (const float*)(a.ws + WS_MODF); const float* ng = a.in[2] + (size_t)l * DM;
    const float* wf_g = a.in[5] + (size_t)l * DM * DIN + 7168; const float* bfl = a.in[10] + l * 16;
    bf16* H = (bf16*)(a.ws + WS_H); float* LF = (float*)(a.ws + WS_LF);
    for (int k = tid; k < DM; k += NTHR) {
#pragma unroll
        for (int c = 0; c < 4; ++c) { const f32x4 x = *(const f32x4*)(wf_g + (size_t)k * DIN + 4 * c);
#pragma unroll
            for (int e = 0; e < 4; ++e) { const int n = 4 * c + e; *(LAS unsigned short*)(WfT + n * 4096 + ((((k >> 3) ^ n) & 255) << 4) + (k & 7) * 2) = (unsigned short)(pk2(x[e], 0.f) & 0xffffu); } } }
    const int mj = lane & 15, mq = lane >> 4;
    for (int rb = bid; rb < M / 64; rb += G) {
        const int b = rb / (SEQ / 64);
        { const bool first = (rb % (SEQ / 64)) == 0; const float* modp = (const float*)(a.ws + WS_MODP); const float* b_ada = a.in[4] + (size_t)l * 6144; float* modfw = (float*)(a.ws + WS_MODF);
          for (int i = 0; i < DM / NTHR; ++i) { const int k = tid + NTHR * i;
            float s0 = b_ada[k], s1 = b_ada[DM + k], s2 = b_ada[2 * DM + k];
#pragma unroll
            for (int kc = 0; kc < MOD_KC; ++kc) { const float* p = modp + (((size_t)kc * 2 + l) * 4 + b) * 6144 + k; s0 += p[0]; s1 += p[DM]; if (first) s2 += p[2 * DM]; }
            gs[k] = ng[k] * (1.0f + s1); sh[k] = s0;
            if (first) modfw[((size_t)l * 4 + b) * 6144 + 4096 + k] = s2; } }
        __syncthreads();
        const int rowb = rb * 64 + wave * 8;
        f32x4 v0[8], v1[8]; v2u tA[8], tB[8];
#define P1_LOADROWS(ROW) do { const f32x4* xr0 = (const f32x4*)(xin + (size_t)(ROW) * DM) + lane; const f32x4* xr1 = xr0 + DM / 4; \
          _Pragma("unroll") for (int j = 0; j < 8; ++j) { v0[j] = __builtin_nontemporal_load(xr0 + 64 * j); v1[j] = __builtin_nontemporal_load(xr1 + 64 * j); } \
          if (T0) { const v2u* t0p = (const v2u*)(T0 + (size_t)(ROW) * DM) + lane; const v2u* t1p = t0p + DM / 4; \
            _Pragma("unroll") for (int j = 0; j < 8; ++j) { tA[j] = t0p[64 * j]; tB[j] = t1p[64 * j]; } } } while (0)
        P1_LOADROWS(rowb);
        for (int rp = 0; rp < 4; ++rp) { const int row = rowb + 2 * rp;
            float ss0 = 0.f, ss1 = 0.f;
            if (T0) {
#pragma unroll
                for (int j = 0; j < 8; ++j) { v0[j] += (f32x4){bflo(tA[j].x), bfhi(tA[j].x), bflo(tA[j].y), bfhi(tA[j].y)}; v1[j] += (f32x4){bflo(tB[j].x), bfhi(tB[j].x), bflo(tB[j].y), bfhi(tB[j].y)}; }
                v2u* x0p = (v2u*)((bf16*)T0 + (size_t)row * DM) + lane; v2u* x1p = x0p + DM / 4;
#pragma unroll
                for (int j = 0; j < 8; ++j) { v2u wa, wb; wa.x = pkh2(v0[j][0], v0[j][1]); wa.y = pkh2(v0[j][2], v0[j][3]); wb.x = pkh2(v1[j][0], v1[j][1]); wb.y = pkh2(v1[j][2], v1[j][3]); x0p[64 * j] = wa; x1p[64 * j] = wb; } }
#pragma unroll
            for (int j = 0; j < 8; ++j) { ss0 += (v0[j][0] * v0[j][0] + v0[j][1] * v0[j][1]) + (v0[j][2] * v0[j][2] + v0[j][3] * v0[j][3]); ss1 += (v1[j][0] * v1[j][0] + v1[j][1] * v1[j][1]) + (v1[j][2] * v1[j][2] + v1[j][3] * v1[j][3]); }
            const float rstd0 = 1.0f / sqrtf(wave_sum(ss0) * (1.0f / DM) + EPS), rstd1 = 1.0f / sqrtf(wave_sum(ss1) * (1.0f / DM) + EPS);
            v2u* o0 = (v2u*)(H + (size_t)row * DM) + lane; v2u* o1 = o0 + DM / 4;
#pragma unroll
            for (int j = 0; j < 8; ++j) { const f32x4 gj = *(const LAS f32x4*)(gs + 4 * lane + 256 * j), sj = *(const LAS f32x4*)(sh + 4 * lane + 256 * j);
                const f32x4 y0 = v0[j] * rstd0 * gj + sj, y1 = v1[j] * rstd1 * gj + sj;
                v2u w0, w1; w0.x = pk2(y0[0], y0[1]); w0.y = pk2(y0[2], y0[3]); w1.x = pk2(y1[0], y1[1]); w1.y = pk2(y1[2], y1[3]);
                o0[64 * j] = w0; o1[64 * j] = w1;
                *(LAS v2u*)(hT + (4 * lane + 256 * j) * 2) = w0; *(LAS v2u*)(hT + 4096 + (4 * lane + 256 * j) * 2) = w1; }
            if (rp < 3) P1_LOADROWS(row + 2);
            f32x4 d0 = (f32x4){0.f, 0.f, 0.f, 0.f}, d1 = d0, d2 = d0, d3 = d0;
            const LAS unsigned char* ap = WfT + mj * 4096; const LAS unsigned char* bp = hT + (mj & 1) * 4096 + mq * 16;
#pragma unroll 4
            for (int st = 0; st < 64; st += 4) {
                const bf16x8 a0 = *(const LAS bf16x8*)(ap + ((((4 * st + mq) ^ mj) & 255) << 4)), b0 = *(const LAS bf16x8*)(bp + 64 * st);
                const bf16x8 a1 = *(const LAS bf16x8*)(ap + ((((4 * st + 4 + mq) ^ mj) & 255) << 4)), b1 = *(const LAS bf16x8*)(bp + 64 * st + 64);
                const bf16x8 a2 = *(const LAS bf16x8*)(ap + ((((4 * st + 8 + mq) ^ mj) & 255) << 4)), b2 = *(const LAS bf16x8*)(bp + 64 * st + 128);
                const bf16x8 a3 = *(const LAS bf16x8*)(ap + ((((4 * st + 12 + mq) ^ mj) & 255) << 4)), b3 = *(const LAS bf16x8*)(bp + 64 * st + 192);
                d0 = __builtin_amdgcn_mfma_f32_16x16x32_bf16(a0, b0, d0, 0, 0, 0); d1 = __builtin_amdgcn_mfma_f32_16x16x32_bf16(a1, b1, d1, 0, 0, 0);
                d2 = __builtin_amdgcn_mfma_f32_16x16x32_bf16(a2, b2, d2, 0, 0, 0); d3 = __builtin_amdgcn_mfma_f32_16x16x32_bf16(a3, b3, d3, 0, 0, 0); }
            const f32x4 d = (d0 + d1) + (d2 + d3);
            if (mj < 2) { const int rr = row + mj;
#pragma unroll
                for (int r = 0; r < 4; ++r) { const int head = 4 * mq + r; const float x = d[r] + bfl[head]; const float lf = fminf(x, 0.f) - log1pf(expf(-fabsf(x)));
                    LF[((size_t)(rr / SEQ) * 16 + head) * SEQ + (rr % SEQ)] = lf; } } }
        __syncthreads();
    }
}
__device__ __forceinline__ void p_final(const Args& a, int vcu, int G, int wave, int lane) {
    const f32x4* fg = (const f32x4*)a.in[12] + lane;
    f32x4 g4[8];
#pragma unroll
    for (int j = 0; j < 8; ++j) g4[j] = fg[64 * j];
    const bf16* T0 = (const bf16*)(a.ws + WS_T0); const bf16* T1 = (const bf16*)(a.ws + WS_H);
    for (int row = vcu * NWAVES + wave; row < M; row += G * NWAVES) {
        const v2u* t0p = (const v2u*)(T0 + (size_t)row * DM) + lane; const v2u* t1p = (const v2u*)(T1 + (size_t)row * DM) + lane;
        f32x4 v[8]; v2u ta[8], tb[8]; float ss = 0.f;
#pragma unroll
        for (int j = 0; j < 8; ++j) { ta[j] = __builtin_nontemporal_load(t0p + 64 * j); tb[j] = __builtin_nontemporal_load(t1p + 64 * j); }
        asm volatile("" : "+v"(ta[0]), "+v"(ta[1]), "+v"(ta[2]), "+v"(ta[3]), "+v"(ta[4]), "+v"(ta[5]), "+v"(ta[6]), "+v"(ta[7]),
                     "+v"(tb[0]), "+v"(tb[1]), "+v"(tb[2]), "+v"(tb[3]), "+v"(tb[4]), "+v"(tb[5]), "+v"(tb[6]), "+v"(tb[7]));
#pragma unroll
        for (int j = 0; j < 8; ++j) { const f32x2h a0 = uph2(ta[j].x), a1 = uph2(ta[j].y); v[j] = (f32x4){a0.x, a0.y, a1.x, a1.y} + (f32x4){bflo(tb[j].x), bfhi(tb[j].x), bflo(tb[j].y), bfhi(tb[j].y)}; }
#pragma unroll
        for (int j = 0; j < 8; ++j) ss += (v[j][0] * v[j][0] + v[j][1] * v[j][1]) + (v[j][2] * v[j][2] + v[j][3] * v[j][3]);
        const float rstd = 1.0f / sqrtf(wave_sum(ss) * (1.0f / DM) + EPS);
        f32x4* orow = (f32x4*)(a.out + (size_t)row * DM) + lane;
#pragma unroll
        for (int j = 0; j < 8; ++j) __builtin_nontemporal_store(v[j] * rstd * g4[j], orow + 64 * j);
    }
}
__device__ __forceinline__ void gmlp_phase(const Args& a, LAS unsigned char* lds, int l, int vcu, int G, int wave, int lane) {
    const bf16* U = (const bf16*)(a.ws + WS_Z); const bf16* V = U + (size_t)M * 1024; const bf16* GA = U + (size_t)2 * M * 1024;
    bf16* Y = (bf16*)(a.ws + WS_Y); const float* STATP = (const float*)(a.ws + WS_STATP);
    const bf16* Wsb = (const bf16*)(a.ws + WS_WS) + (size_t)l * 8 * 128 * 128;
    const float* bs = a.in[9] + (size_t)l * 8 * 128; const float* lng = a.in[6] + (size_t)l * WA; const float* lnb = a.in[7] + (size_t)l * WA;
    constexpr int LTP = 272;
    LAS unsigned char* LT = lds + wave * (64 * LTP);
    const int hi = lane >> 5, r32 = lane & 31;
    LAS float* lnL = (LAS float*)(lds + 8 * 64 * LTP);
    { const int t4 = (wave * 64 + lane) * 4; *(LAS f32x4*)(lnL + t4) = t4 < 1024 ? *(const f32x4*)(lng + t4) : *(const f32x4*)(lnb + t4 - 1024); }
    __syncthreads();
    for (int id = vcu * NWAVES + wave; id < 2048; id += G * NWAVES) {
        const int dh = id & 1, hd = (id >> 1) & 7, n = (id >> 4) & 31, b = id >> 9; const size_t R0 = (size_t)b * SEQ + (size_t)n * 128; const int cb = hd * 128 + dh * 64;
        const f32x4* sp = (const f32x4*)(STATP + (R0 + 2 * lane) * 32);
        const bf16* vp0 = V + (R0 + 2 * lane) * 1024 + cb; const bf16* vp1 = vp0 + 1024;
        f32x4 st[16]; v4u va[8], vb[8];
#pragma unroll
        for (int j = 0; j < 16; ++j) st[j] = sp[j];
#pragma unroll
        for (int c = 0; c < 8; ++c) { va[c] = *(const v4u*)(vp0 + 8 * c); vb[c] = *(const v4u*)(vp1 + 8 * c); }
        asm volatile("" : "+v"(st[0]), "+v"(st[1]), "+v"(st[2]), "+v"(st[3]), "+v"(st[4]), "+v"(st[5]), "+v"(st[6]), "+v"(st[7]), "+v"(st[8]), "+v"(st[9]), "+v"(st[10]), "+v"(st[11]), "+v"(st[12]), "+v"(st[13]), "+v"(st[14]), "+v"(st[15]));
        asm volatile("" : "+v"(va[0]), "+v"(va[1]), "+v"(va[2]), "+v"(va[3]), "+v"(va[4]), "+v"(va[5]), "+v"(va[6]), "+v"(va[7]), "+v"(vb[0]), "+v"(vb[1]), "+v"(vb[2]), "+v"(vb[3]), "+v"(vb[4]), "+v"(vb[5]), "+v"(vb[6]), "+v"(vb[7]));
        float mean0, rs0, mean1, rs1;
        { float s0 = 0.f, q0 = 0.f, s1 = 0.f, q1 = 0.f;
#pragma unroll
          for (int j = 0; j < 8; ++j) { const f32x4 x = st[j], y = st[8 + j]; s0 += x[0] + x[2]; q0 += x[1] + x[3]; s1 += y[0] + y[2]; q1 += y[1] + y[3]; }
          mean0 = s0 * (1.0f / 1024.0f); mean1 = s1 * (1.0f / 1024.0f);
          rs0 = 1.0f / sqrtf(fmaxf(q0 * (1.0f / 1024.0f) - mean0 * mean0, 0.f) + EPS); rs1 = 1.0f / sqrtf(fmaxf(q1 * (1.0f / 1024.0f) - mean1 * mean1, 0.f) + EPS); }
#pragma unroll
        for (int c = 0; c < 8; ++c) {
            const f32x4 ga = *(const LAS f32x4*)(lnL + cb + 8 * c), gb = *(const LAS f32x4*)(lnL + cb + 8 * c + 4), ba = *(const LAS f32x4*)(lnL + 1024 + cb + 8 * c), bb = *(const LAS f32x4*)(lnL + 1024 + cb + 8 * c + 4);
#pragma unroll
            for (int e = 0; e < 4; ++e) { const float gl = e < 2 ? ga[2 * e] : gb[2 * e - 4], gh = e < 2 ? ga[2 * e + 1] : gb[2 * e - 3], bl = e < 2 ? ba[2 * e] : bb[2 * e - 4], bh = e < 2 ? ba[2 * e + 1] : bb[2 * e - 3];
                const float x0 = (bflo(va[c][e]) - mean0) * rs0 * gl + bl, x1 = (bflo(vb[c][e]) - mean1) * rs1 * gl + bl;
                const float y0 = (bfhi(va[c][e]) - mean0) * rs0 * gh + bh, y1 = (bfhi(vb[c][e]) - mean1) * rs1 * gh + bh;
                const int d0 = 8 * c + 2 * e, d1 = d0 + 1; const int e0 = d0 & 31, e1 = d1 & 31;
                const int sl0 = 32 * (d0 >> 5) + 8 * ((e0 >> 2) & 3) + 4 * (e0 >> 4) + (e0 & 3), sl1 = 32 * (d1 >> 5) + 8 * ((e1 >> 2) & 3) + 4 * (e1 >> 4) + (e1 & 3);
                *(LAS unsigned*)(LT + sl0 * LTP + 4 * lane) = pk2(x0, x1);
                *(LAS unsigned*)(LT + sl1 * LTP + 4 * lane) = pk2(y0, y1); } }
        bf16x8 af[2][8];
#pragma unroll
        for (int dt = 0; dt < 2; ++dt)
#pragma unroll
            for (int kk = 0; kk < 8; ++kk) af[dt][kk] = *(const LAS bf16x8*)(LT + (32 * dt + r32) * LTP + (16 * kk + 8 * hi) * 2);
#pragma unroll
        for (int ps = 0; ps < 2; ++ps) {
            f32x16 acc[2][2];
            bf16x8 wfr[2][8];
#pragma unroll
            for (int t2 = 0; t2 < 2; ++t2) { const int tt = 2 * ps + t2; const bf16* Wrow = Wsb + ((size_t)hd * 128 + tt * 32 + r32) * 128 + 8 * hi;
#pragma unroll
                for (int kk = 0; kk < 2 * tt + 2; ++kk) wfr[t2][kk] = *(const bf16x8*)(Wrow + 16 * kk); }
#pragma unroll
            for (int t2 = 0; t2 < 2; ++t2) { const int tt = 2 * ps + t2; acc[0][t2] = f32x16{}; acc[1][t2] = f32x16{}; const int tl = tt * 32 + r32;
#pragma unroll
                for (int kk = 0; kk < 2 * tt + 2; ++kk) { bf16x8 wf = wfr[t2][kk];
                    if (kk >= 2 * tt) {
#pragma unroll
                        for (int e = 0; e < 8; ++e) if (16 * kk + 8 * hi + e > tl) wf[e] = 0; }
                    acc[0][t2] = __builtin_amdgcn_mfma_f32_32x32x16_bf16(af[0][kk], wf, acc[0][t2], 0, 0, 0);
                    acc[1][t2] = __builtin_amdgcn_mfma_f32_32x32x16_bf16(af[1][kk], wf, acc[1][t2], 0, 0, 0); } }
#pragma unroll
            for (int t2 = 0; t2 < 2; ++t2)
#pragma unroll
                for (int dt = 0; dt < 2; ++dt) { LAS unsigned char* e = LT + (32 * t2 + r32) * LTP + (32 * dt + 16 * hi) * 4;
#pragma unroll
                    for (int q = 0; q < 4; ++q) *(LAS f32x4*)(e + 16 * q) = (f32x4){acc[dt][t2][4 * q], acc[dt][t2][4 * q + 1], acc[dt][t2][4 * q + 2], acc[dt][t2][4 * q + 3]}; }
            const int ch = lane & 7, rr = lane >> 3;
            v4u uu[8], gg[8]; float bsr[8];
#pragma unroll
            for (int i = 0; i < 8; ++i) { const int tl = 64 * ps + rr + 8 * i; const size_t row = R0 + tl; const int col = cb + 8 * ch;
                uu[i] = __builtin_nontemporal_load((const v4u*)(U + row * 1024 + col)); gg[i] = __builtin_nontemporal_load((const v4u*)(GA + row * 1024 + col)); bsr[i] = bs[hd * 128 + tl]; }
            asm volatile("" : "+v"(uu[0]), "+v"(uu[1]), "+v"(uu[2]), "+v"(uu[3]), "+v"(uu[4]), "+v"(uu[5]), "+v"(uu[6]), "+v"(uu[7]), "+v"(gg[0]), "+v"(gg[1]), "+v"(gg[2]), "+v"(gg[3]), "+v"(gg[4]), "+v"(gg[5]), "+v"(gg[6]), "+v"(gg[7]));
#pragma unroll
            for (int i = 0; i < 8; ++i) { const int tloc = rr + 8 * i; const size_t row = R0 + 64 * ps + tloc; const int col = cb + 8 * ch; const float bsv = bsr[i];
                const f32x4 e0 = *(const LAS f32x4*)(LT + tloc * LTP + ch * 32), e1 = *(const LAS f32x4*)(LT + tloc * LTP + ch * 32 + 16);
                v4u w; w.x = pk2(bflo(uu[i].x) * (e0[0] + bsv) * bflo(gg[i].x), bfhi(uu[i].x) * (e0[1] + bsv) * bfhi(gg[i].x)); w.y = pk2(bflo(uu[i].y) * (e0[2] + bsv) * bflo(gg[i].y), bfhi(uu[i].y) * (e0[3] + bsv) * bfhi(gg[i].y));
                w.z = pk2(bflo(uu[i].z) * (e1[0] + bsv) * bflo(gg[i].z), bfhi(uu[i].z) * (e1[1] + bsv) * bfhi(gg[i].z)); w.w = pk2(bflo(uu[i].w) * (e1[2] + bsv) * bflo(gg[i].w), bfhi(uu[i].w) * (e1[3] + bsv) * bfhi(gg[i].w));
                *(v4u*)(Y + row * 2048 + col) = w; }
        }
    }
    __syncthreads();
}

__device__ __forceinline__ void fox_scan(const Args& a, LAS unsigned char* lds, int bh, int tid, int lane, int wid) {
    const float* LF = (const float*)(a.ws + WS_LF) + (size_t)bh * SEQ; float* NBg = (float*)(a.ws + WS_NB) + (size_t)bh * SEQ; LAS float* wt = (LAS float*)lds;
    const f32x4 x0 = *(const f32x4*)(LF + 8 * tid), x1 = *(const f32x4*)(LF + 8 * tid + 4);
    float v[8] = {x0[0], x0[1], x0[2], x0[3], x1[0], x1[1], x1[2], x1[3]};
#pragma unroll
    for (int i = 1; i < 8; ++i) v[i] += v[i - 1];
    const float tot = v[7]; float x = tot;
#pragma unroll
    for (int o = 1; o < 64; o <<= 1) { const float y = __shfl_up(x, o); if (lane >= o) x += y; }
    if (lane == 63) wt[wid] = x;
    __syncthreads();
    float off = x - tot;
    for (int w = 0; w < wid; ++w) off += wt[w];
    f32x4 o0, o1;
#pragma unroll
    for (int i = 0; i < 4; ++i) { o0[i] = -(off + v[i]) * 1.4426950408889634f; o1[i] = -(off + v[4 + i]) * 1.4426950408889634f; }
    *(f32x4*)(NBg + 8 * tid) = o0; *(f32x4*)(NBg + 8 * tid + 4) = o1;
    __syncthreads();
}

constexpr int N_PHASES = 10;
__global__ void __launch_bounds__(NTHR, 2) fwd_megakernel(Args args) {
    extern __shared__ __attribute__((aligned(16))) unsigned char lds_raw[];
    LAS unsigned char* lds = (LAS unsigned char*)lds_raw;
    const int G = gridDim.x, bx = blockIdx.x, vcu = (G % 8 == 0) ? (bx % 8) * (G / 8) + bx / 8 : bx;
    unsigned char* ws = args.ws;
    volatile LAS unsigned* bst = (volatile LAS unsigned*)(lds + LDS_PHASE);
    if (threadIdx.x < 2) bst[threadIdx.x] = 0u;
    __syncthreads();
    const XcdBarrier bar = xcd_barrier_post((unsigned*)(ws + WS_BAR), bst);
    if (args.ph_lo < 0) cg::this_grid().sync();
    for (int idx = args.ph_lo; idx < args.ph_hi; ++idx) {
        const int ph = (PROBE_DUP >= 0 && idx > PROBE_DUP) ? (idx <= PROBE_DUP + PROBE_REP ? PROBE_DUP : idx - PROBE_REP) : idx; const bool dup_pass = (PROBE_DUP >= 0 && idx > PROBE_DUP && idx <= PROBE_DUP + PROBE_REP); (void)dup_pass;
        int tid = threadIdx.x; asm volatile("" : "+v"(tid));
        const int lane = tid & 63, wave = __builtin_amdgcn_readfirstlane(tid >> 6);
#ifndef NO_P0
        if (ph == 0) p0_prologue(args, lds, vcu, G, wave, lane, dup_pass); else
#endif
        if (false) {}
        else if (ph == 9) p_final(args, vcu, G, wave, lane);
        else {
            const int l = (ph - 1) >> 2, sub = (ph - 1) & 3;
#ifndef NO_P1
            if (sub == 0) p1_modnorm(args, lds, l, args.in[0], l == 0 ? (const bf16*)nullptr : (const bf16*)(ws + WS_T0), vcu, G, tid, wave, lane);
            else
#endif
            if (sub == 1) {
#ifndef NO_GIN
                pg8::Gemm g{(const pg8::bf16_t*)(ws + WS_H), (const pg8::bf16_t*)(ws + WS_WIN) + (size_t)l * NPAD * DM, M, NPAD, DM};
                pg8::StaticOrder S; S.init(M, NPAD, G, bx);
                if (!dup_pass) for (int bh = bx; bh < 64; bh += G) fox_scan(args, lds, bh, tid, lane, wave);
                pg8::EpiIn E{(pg8::bf16_t*)(ws + WS_Z), (float*)(ws + WS_STATP), attn_body::C2, (unsigned*)(ws + WS_KN2) + l * 128};
                pg8::gemm_phase<pg8::EpiIn, pg8::StaticOrder, true, true>(lds, g, S, E, tid);
#endif
            } else if (sub == 2) {
#ifndef NO_GMLP
                if (!(dup_pass && PROBE_PART == 2)) gmlp_phase(args, lds, l, vcu, G, wave, lane);
#endif
#ifndef NO_ATTN
                const attn_body::bf16* Zb = (const attn_body::bf16*)(ws + WS_Z);
                constexpr long QOFF = (long)WS_Z + 3L * M * 1024 * 2;
                const attn_body::AttnTensors AT{Zb + (size_t)3 * M * 1024, (long)M * 1024, (long)WS_Y + 2048 - QOFF, (long)WS_NB - QOFF};
                if (!(dup_pass && PROBE_PART == 1)) attn_body::attn_phase<20>((char*)lds_raw, AT, G, bx, tid, (unsigned*)(ws + WS_QCTR) + l + (dup_pass ? 2 : 0), (const unsigned*)(ws + WS_KN2) + l * 128);
#endif
            } else {
#ifndef NO_GOUT
                pg8::Gemm g{(const pg8::bf16_t*)(ws + WS_Y), (const pg8::bf16_t*)(ws + WS_WOUT) + (size_t)l * DM * DM, M, DM, DM};
                pg8::StaticOrder S; S.init(M, DM, G, bx);
                pg8::EpiOut E{(pg8::bf16_t*)(ws + (l == 0 ? WS_T0 : WS_H)), (const float*)(ws + WS_MODF) + (size_t)l * 4 * 6144 + 4096};
                pg8::gemm_phase<pg8::EpiOut, pg8::StaticOrder, true, true>(lds, g, S, E, tid);
#endif
            }
        }
        if (idx + 1 < args.ph_hi) xcd_barrier(bar);
    }
}

extern "C" void kernel_launch(void* const* d_in, const int* in_sizes, int n_in, void* d_out, int out_size, void* d_ws, size_t ws_size, hipStream_t stream) {
    static int grid = 0;
    if (grid == 0) {
        if (n_in != 13 || out_size != M * DM || ws_size < WS_END) { fprintf(stderr, "kernel_launch: unexpected shapes (n_in %d, out %d, ws %zu)\n", n_in, out_size, ws_size); grid = -1; return; }
        int dev = 0, cus = 0, per_cu = 0;
        hipGetDevice(&dev); hipDeviceGetAttribute(&cus, hipDeviceAttributeMultiprocessorCount, dev);
        if (hipFuncSetAttribute((const void*)fwd_megakernel, hipFuncAttributeMaxDynamicSharedMemorySize, LDS_BYTES) != hipSuccess) { fprintf(stderr, "kernel_launch: hipFuncSetAttribute failed\n"); grid = -1; return; }
        if (hipOccupancyMaxActiveBlocksPerMultiprocessor(&per_cu, (const void*)fwd_megakernel, NTHR, LDS_BYTES) != hipSuccess || per_cu < 1) { fprintf(stderr, "kernel_launch: occupancy query says %d\n", per_cu); per_cu = 1; }
        (void)hipGetLastError();
        grid = cus;
        fprintf(stderr, "kernel_launch: cus %d per_cu %d grid %d\n", cus, per_cu, grid);
    }
    if (grid < 0) return;
    if (hipMemsetAsync((char*)d_ws + WS_BAR, 0, BAR_ZERO_BYTES, stream) != hipSuccess) { fprintf(stderr, "kernel_launch: memset failed\n"); return; }
    Args a{};
    for (int i = 0; i < 13; ++i) a.in[i] = (const float*)d_in[i];
    a.out = (float*)d_out; a.ws = (unsigned char*)d_ws;
#if MK_N_LAUNCHES == 1
    a.ph_lo = 0; a.ph_hi = N_PHASES + (PROBE_DUP >= 0 ? PROBE_REP : 0);
    void* kargs[] = {&a};
    hipError_t e = hipLaunchCooperativeKernel((const void*)fwd_megakernel, dim3(grid), dim3(NTHR), kargs, LDS_BYTES, stream);
    if (e != hipSuccess) fprintf(stderr, "kernel_launch: cooperative launch failed: %s (grid %d)\n", hipGetErrorString(e), grid);
#else
    for (int ph = 0; ph < N_PHASES; ++ph) { a.ph_lo = ph; a.ph_hi = ph + 1; hipLaunchKernelGGL(fwd_megakernel, dim3(grid), dim3(NTHR), LDS_BYTES, stream, a); }
#endif
}
```

```cpp
#include <hip/hip_runtime.h>
#include <hip/hip_cooperative_groups.h>
#include <hip/hip_bf16.h>
#include <cstdio>
#include <cstdint>
#include <cmath>
namespace cg = cooperative_groups;
#ifndef PROBE_DUP
#define PROBE_DUP -1
#endif
#ifndef PROBE_REP
#define PROBE_REP 1
#endif
#ifndef PROBE_PART
#define PROBE_PART 0
#endif
#ifndef MK_N_LAUNCHES
#define MK_N_LAUNCHES 1
#endif
namespace pg8 {
#define PG8_LAS __attribute__((address_space(3)))
typedef unsigned short bf16_t;
typedef short bf16x8 __attribute__((ext_vector_type(8)));
typedef float f32x4 __attribute__((ext_vector_type(4)));
typedef unsigned u32x4 __attribute__((ext_vector_type(4)));
constexpr int BM = 256, BK = 64, HALF = 128, HTB = HALF * BK * 2  , STAGE_BYTES = 8 * HTB, NXCD = 8, WGM = 8;

__host__ __device__ __forceinline__ int lds_byte(int r, int c) { const int st = (r >> 4) * 2 + (c >> 5), rr = r & 15, cc = c & 31, ob = rr * 64 + cc * 2; return st * 1024 + (ob ^ (((ob >> 9) & 1) << 5)); }
__host__ __device__ __forceinline__ void stage_rc(int b, int& R, int& C) { const int st = b / 1024, sb = b % 1024, swz = sb ^ (((sb >> 9) & 1) << 5); R = (st >> 1) * 16 + swz / 64; C = (st & 1) * 32 + (swz % 64) / 2; }
__host__ __device__ __forceinline__ int perm32(int rho) { const int n = rho >> 4, i = rho & 15; return 8 * (i >> 2) + 4 * n + (i & 3); }

struct Unit { int pm, pn; };
struct Gemm { const bf16_t* A; const bf16_t* Bt; int M, N, K; };

struct StaticOrder {
    int nM, nN, nwg, G, c;
    __host__ __device__ void init(int M, int N, int G_, int c_) { nM = M / BM; nN = N / BM; nwg = nM * nN; G = G_; c = c_; }
    __host__ __device__ bool next(int i, Unit& u) const {
        const long L = (long)i * G + c; if (L >= nwg) return false;
        int wgid = (int)L; { const int q = nwg / NXCD, r = nwg % NXCD, xcd = wgid % NXCD, off = wgid / NXCD; wgid = (xcd < r ? xcd * (q + 1) : r * (q + 1) + (xcd - r) * q) + off; }
        const int nig = WGM * nN, gid = wgid / nig, fm = gid * WGM, gsz = (nM - fm) < WGM ? (nM - fm) : WGM;
        u.pm = fm + ((wgid % nig) % gsz); u.pn = (wgid % nig) / gsz; return true;
    }
    __device__ __forceinline__ void a_ready(const Unit&) const {}
    __device__ __forceinline__ void done(const Unit&) const {}
};

__device__ __forceinline__ unsigned cvt_pk_bf16(float lo, float hi) { unsigned r; asm volatile("v_cvt_pk_bf16_f32 %0, %1, %2" : "=v"(r) : "v"(lo), "v"(hi)); return r; }
typedef float f32x2 __attribute__((ext_vector_type(2)));
__device__ __forceinline__ f32x2 gelu_pk(f32x2 v) {
    const f32x2 av = __builtin_elementwise_abs(v), d = av * 0.2316418882f + 1.0f;
    f32x2 t; t.x = __builtin_amdgcn_rcpf(d.x); t.y = __builtin_amdgcn_rcpf(d.y);
    f32x2 q = t * 0.5307027145f + (-0.7265760135f); q = q * t + 0.7107068705f; q = q * t + (-0.142248368f); q = q * t + 0.127414796f; q = q * t;
    const f32x2 s = (v * v) * (-0.72134752044f);
    f32x2 e; e.x = __builtin_amdgcn_exp2f(s.x); e.y = __builtin_amdgcn_exp2f(s.y);
    const f32x2 m = v * (q * e), r = v - m;
    f32x2 o; o.x = v.x < 0.f ? m.x : r.x; o.y = v.y < 0.f ? m.y : r.y; return o;
}
constexpr int P_M = 16384, P_SEQ = 4096;
__device__ __forceinline__ f32x4 silu4(f32x4 v) {
    f32x4 o;
#pragma unroll
    for (int i = 0; i < 4; ++i) o[i] = v[i] * __builtin_amdgcn_rcpf(1.0f + __builtin_amdgcn_exp2f(v[i] * -1.4426950408889634f));
    return o;
}
__device__ __forceinline__ f32x4 gelu4(f32x4 v) { const f32x2 a = gelu_pk((f32x2){v[0], v[1]}), b = gelu_pk((f32x2){v[2], v[3]}); return (f32x4){a.x, a.y, b.x, b.y}; }
struct EpiIn {
    static constexpr bool PERM = true, AFTER_DRAIN = false;
    bf16_t* Z; float* STATP; float qscale; unsigned* KN2;
    template <int MODE> __device__ __forceinline__ void store(const f32x4 (&acc)[2][2][4][2], bf16_t* base, int row0, int col0, int sidx) const {
        float kmx[2] = {0.f, 0.f};
#pragma unroll
        for (int ai = 0; ai < 2; ++ai)
#pragma unroll
            for (int m = 0; m < 4; ++m) { bf16_t* rowp = base + (size_t)(row0 + ai * HALF + m * 16) * 1024 + col0; float ssum = 0.f, sq = 0.f;
#pragma unroll
                for (int bj = 0; bj < 2; ++bj) { f32x4 v0 = acc[ai][bj][m][0], v1 = acc[ai][bj][m][1];
                    if (MODE == 1 || MODE == 4) { v0 = gelu4(v0); v1 = gelu4(v1); }
                    if (MODE == 2) { v0 = silu4(v0); v1 = silu4(v1); }
                    if (MODE == 3) { v0 = v0 * qscale; v1 = v1 * qscale; }
                    u32x4 w; w.x = cvt_pk_bf16(v0[0], v0[1]); w.y = cvt_pk_bf16(v0[2], v0[3]); w.z = cvt_pk_bf16(v1[0], v1[1]); w.w = cvt_pk_bf16(v1[2], v1[3]);
                    *(u32x4*)(rowp + bj * HALF) = w;
                    if (MODE == 4) {
#pragma unroll
                        for (int e = 0; e < 4; ++e) { const float lo = __uint_as_float(w[e] << 16), hi = __uint_as_float(w[e] & 0xffff0000u); ssum += lo + hi; sq += lo * lo + hi * hi; } }
                    if (MODE == 5) { float kq = 0.f;
#pragma unroll
                        for (int e = 0; e < 4; ++e) { const float lo = __uint_as_float(w[e] << 16), hi = __uint_as_float(w[e] & 0xffff0000u); kq += lo * lo + hi * hi; }
                        kq += __shfl_xor(kq, 16); kq += __shfl_xor(kq, 32); kmx[bj] = fmaxf(kmx[bj], kq); } }
                if (MODE == 4) { ssum += __shfl_xor(ssum, 16); sq += __shfl_xor(sq, 16); ssum += __shfl_xor(ssum, 32); sq += __shfl_xor(sq, 32);
                    if (sidx >= 0) { float* p = STATP + ((size_t)(row0 + ai * HALF + m * 16) * 16 + sidx) * 2; p[0] = ssum; p[1] = sq; } } }
        if (MODE == 5) {
#pragma unroll
            for (int bj = 0; bj < 2; ++bj) { float v = kmx[bj]; v = fmaxf(v, __shfl_xor(v, 1)); v = fmaxf(v, __shfl_xor(v, 2)); v = fmaxf(v, __shfl_xor(v, 4)); v = fmaxf(v, __shfl_xor(v, 8));
                if ((threadIdx.x & 63) == 0) atomicMax(KN2 + sidx + bj * 4, __float_as_uint(v)); } }
    }
    __device__ __forceinline__ void operator()(const f32x4 (&acc)[2][2][4][2], const Unit& u, int wr, int wc, int fr, int fq) const {
        const int row0 = u.pm * BM + wr * 64 + fr;
        const int t = u.pn >> 2; bf16_t* base = Z + (size_t)t * ((size_t)P_M * 1024); const int col0 = (u.pn & 3) * BM + wc * 32 + 8 * fq;
        if (t == 0) store<1>(acc, base, row0, col0, -1);
        else if (t == 1) store<4>(acc, base, row0, col0, fq == 0 ? (u.pn & 3) * 4 + wc : -1);
        else if (t == 2 || t == 6) store<2>(acc, base, row0, col0, -1);
        else if (t == 3) store<3>(acc, base, row0, col0, -1);
        else if (t == 4) store<5>(acc, base, row0, col0, ((row0 / P_SEQ) * 16 + (u.pn & 3) * 4 + (wc >> 1)) * 2 + (wc & 1));
        else store<0>(acc, base, row0, col0, -1);
    }
};
struct EpiOut {
    static constexpr bool PERM = true, AFTER_DRAIN = false;
    bf16_t* T; const float* gate;
    __device__ __forceinline__ void operator()(const f32x4 (&acc)[2][2][4][2], const Unit& u, int wr, int wc, int fr, int fq) const {
        const int row0 = u.pm * BM + wr * 64 + fr, col0 = u.pn * BM + wc * 32 + 8 * fq; const int b = (u.pm * BM) / P_SEQ;
        f32x4 gv[2][2];
#pragma unroll
        for (int bj = 0; bj < 2; ++bj)
#pragma unroll
            for (int n = 0; n < 2; ++n) gv[bj][n] = *(const f32x4*)(gate + (size_t)b * 6144 + col0 + bj * HALF + 4 * n);
#pragma unroll
        for (int ai = 0; ai < 2; ++ai)
#pragma unroll
            for (int m = 0; m < 4; ++m) { bf16_t* rowp = T + (size_t)(row0 + ai * HALF + m * 16) * 2048 + col0;
#pragma unroll
                for (int bj = 0; bj < 2; ++bj) { const f32x4 v0 = acc[ai][bj][m][0] * gv[bj][0], v1 = acc[ai][bj][m][1] * gv[bj][1];
                    u32x4 w; w.x = cvt_pk_bf16(v0[0], v0[1]); w.y = cvt_pk_bf16(v0[2], v0[3]); w.z = cvt_pk_bf16(v1[0], v1[1]); w.w = cvt_pk_bf16(v1[2], v1[3]);
                    *(u32x4*)(rowp + bj * HALF) = w; } }
    }
};
template <class Epi, class Sched, bool ALIGN_EPI = false, bool SP2 = false>
__device__ __forceinline__ void gemm_phase(PG8_LAS unsigned char* lds, const Gemm g, const Sched& S, const Epi& E, const int tid) {
    const int  wid = __builtin_amdgcn_readfirstlane(tid >> 6), lane = tid & 63, wr = wid >> 2, wc = wid & 3, fr = lane & 15, fq = lane >> 4;
    const int K = g.K, nt = K / BK;
    unsigned voffA[2], voffB[2];
#pragma unroll
    for (int i = 0; i < 2; ++i) { int R, C; stage_rc(tid * 16 + i * 8192, R, C); const int Rb = Epi::PERM ? ((R & ~31) + perm32(R & 31)) : R;
        voffA[i] = (unsigned)(R * K + C) * 2u; voffB[i] = (unsigned)(Rb * K + C) * 2u; }
    const size_t kstep = (size_t)(BK * 2);
    const size_t hstep = (size_t)HALF * K * 2;
    const size_t tstep = 2 * hstep;
    const unsigned ldsw = (unsigned)wid * 1024u;
    const int aoff = lds_byte(wr * 64 + fr, fq * 8), boff = lds_byte(wc * 32 + fr, fq * 8);
#define PG8_SA(b, h) (((b) * 2 + (h)) * HTB)
#define PG8_SB(b, h) ((4 + (b) * 2 + (h)) * HTB)
#define PG8_STAGE(bufoff, gbase, voff) do { _Pragma("unroll") for (int _i = 0; _i < 2; ++_i) \
        __builtin_amdgcn_global_load_lds((const unsigned*)((const char*)(gbase) + (voff)[_i]), (PG8_LAS unsigned*)(lds + (bufoff) + ldsw + _i * 8192), 16, 0, 0); } while (0)
#define PG8_LDA(dst, b, h) do { _Pragma("unroll") for (int m = 0; m < 4; ++m) _Pragma("unroll") for (int k = 0; k < 2; ++k) dst[m][k] = *(const PG8_LAS bf16x8*)(lds + PG8_SA(b, h) + aoff + m * 2048 + k * 1024); } while (0)
#define PG8_LDB(dst, b, h) do { _Pragma("unroll") for (int n = 0; n < 2; ++n) _Pragma("unroll") for (int k = 0; k < 2; ++k) dst[n][k] = *(const PG8_LAS bf16x8*)(lds + PG8_SB(b, h) + boff + n * 2048 + k * 1024); } while (0)
#define PG8_MMA(ai, bj, At, Bt) do { __builtin_amdgcn_s_setprio(1); _Pragma("unroll") for (int m = 0; m < 4; ++m) _Pragma("unroll") for (int n = 0; n < 2; ++n) _Pragma("unroll") for (int k = 0; k < 2; ++k) \
        acc[ai][bj][m][n] = __builtin_amdgcn_mfma_f32_16x16x32_bf16(Bt[n][k], At[m][k], acc[ai][bj][m][n], 0, 0, 0); __builtin_amdgcn_s_setprio(0); } while (0)
#define PG8_WAIT_V(n) asm volatile("s_waitcnt vmcnt(" #n ")" ::: "memory")
#define PG8_WAIT_L(n) asm volatile("s_waitcnt lgkmcnt(" #n ")" ::: "memory")
#define PG8_BAR __builtin_amdgcn_s_barrier()
#define PG8_SCHED __builtin_amdgcn_sched_barrier(0)
    Unit cur, nxt; int ui = 0;
    if (!S.next(0, cur)) return;
    f32x4 acc[2][2][4][2];
#pragma unroll
    for (int a = 0; a < 2; ++a)
#pragma unroll
        for (int b = 0; b < 2; ++b)
#pragma unroll
            for (int m = 0; m < 4; ++m)
#pragma unroll
                for (int n = 0; n < 2; ++n) acc[a][b][m][n] = (f32x4){0.f, 0.f, 0.f, 0.f};
    bf16x8 At[4][2], B0[2][2], B1[2][2];
    const char* cA = (const char*)g.A + (size_t)cur.pm * tstep; const char* cB = (const char*)g.Bt + (size_t)cur.pn * tstep;
    S.a_ready(cur);
    if constexpr (SP2) {
        PG8_STAGE(PG8_SB(0, 0), cB, voffB); PG8_STAGE(PG8_SB(0, 1), cB + hstep, voffB); PG8_STAGE(PG8_SA(0, 0), cA, voffA); PG8_STAGE(PG8_SA(0, 1), cA + hstep, voffA);
        if (wr == 1) PG8_BAR;
        PG8_WAIT_V(2); PG8_BAR;
        PG8_STAGE(PG8_SB(1, 0), cB + kstep, voffB); PG8_STAGE(PG8_SA(1, 0), cA + kstep, voffA); PG8_STAGE(PG8_SB(1, 1), cB + hstep + kstep, voffB);
        PG8_WAIT_V(6); PG8_BAR;
    } else {
        PG8_STAGE(PG8_SB(0, 0), cB, voffB); PG8_STAGE(PG8_SA(0, 0), cA, voffA); PG8_STAGE(PG8_SB(0, 1), cB + hstep, voffB); PG8_STAGE(PG8_SA(0, 1), cA + hstep, voffA);
        if (wr == 1) PG8_BAR;
        PG8_WAIT_V(4); PG8_BAR;
        PG8_STAGE(PG8_SB(1, 0), cB + kstep, voffB); PG8_STAGE(PG8_SA(1, 0), cA + kstep, voffA); PG8_STAGE(PG8_SB(1, 1), cB + hstep + kstep, voffB);
        PG8_WAIT_V(6); PG8_BAR;
    }
    for (;;) {
        const bool has_next = S.next(ui + 1, nxt);
        const char* nA = has_next ? (const char*)g.A + (size_t)nxt.pm * tstep : cA; const char* nB = has_next ? (const char*)g.Bt + (size_t)nxt.pn * tstep : cB;
        for (int t = 0; t < nt; t += 2) {
            const bool last = (t == nt - 2);
            const char* a1 = cA + (size_t)(t + 1) * kstep;
            const char* a2 = last ? nA : cA + (size_t)(t + 2) * kstep; const char* b2 = last ? nB : cB + (size_t)(t + 2) * kstep;
            const char* a3 = a2 + kstep; const char* b3 = b2 + kstep;
            if (last && has_next) S.a_ready(nxt);
            if constexpr (SP2) {
            PG8_LDB(B0, 0, 0); PG8_LDB(B1, 0, 1); PG8_SCHED; PG8_LDA(At, 0, 0); PG8_STAGE(PG8_SA(1, 1), a1 + hstep, voffA);
            PG8_WAIT_V(8); PG8_WAIT_L(0); PG8_BAR; PG8_MMA(0, 0, At, B0); PG8_MMA(0, 1, At, B1); PG8_BAR; PG8_SCHED;
            PG8_LDA(At, 0, 1); PG8_STAGE(PG8_SB(0, 0), b2, voffB); PG8_STAGE(PG8_SB(0, 1), b2 + hstep, voffB); PG8_STAGE(PG8_SA(0, 0), a2, voffA);
            PG8_WAIT_V(8); PG8_WAIT_L(0); PG8_BAR; PG8_MMA(1, 0, At, B0); PG8_MMA(1, 1, At, B1); PG8_BAR; PG8_SCHED;
            PG8_LDB(B0, 1, 0); PG8_LDB(B1, 1, 1); PG8_SCHED; PG8_LDA(At, 1, 0); PG8_STAGE(PG8_SA(0, 1), a2 + hstep, voffA);
            PG8_WAIT_V(8); PG8_WAIT_L(0); PG8_BAR; PG8_MMA(0, 0, At, B0); PG8_MMA(0, 1, At, B1); PG8_BAR; PG8_SCHED;
            PG8_LDA(At, 1, 1); PG8_STAGE(PG8_SB(1, 0), b3, voffB); PG8_STAGE(PG8_SB(1, 1), b3 + hstep, voffB); PG8_STAGE(PG8_SA(1, 0), a3, voffA);
            PG8_WAIT_V(8); PG8_WAIT_L(0); PG8_BAR; PG8_MMA(1, 0, At, B0); PG8_MMA(1, 1, At, B1); PG8_BAR; PG8_SCHED;
            } else {
            PG8_LDB(B0, 0, 0); PG8_SCHED; PG8_LDA(At, 0, 0); PG8_STAGE(PG8_SA(1, 1), a1 + hstep, voffA);
            PG8_WAIT_L(8); PG8_BAR; PG8_WAIT_L(0); PG8_MMA(0, 0, At, B0); PG8_BAR; PG8_SCHED;
            PG8_LDB(B1, 0, 1); PG8_STAGE(PG8_SB(0, 0), b2, voffB);
            PG8_BAR; PG8_WAIT_L(0); PG8_MMA(0, 1, At, B1); PG8_BAR;
            PG8_LDA(At, 0, 1); PG8_STAGE(PG8_SA(0, 0), a2, voffA);
            PG8_BAR; PG8_WAIT_L(0); PG8_MMA(1, 0, At, B0); PG8_BAR; PG8_SCHED;
            PG8_STAGE(PG8_SB(0, 1), b2 + hstep, voffB);
            PG8_WAIT_V(6); PG8_BAR; PG8_MMA(1, 1, At, B1); PG8_BAR;
            PG8_LDB(B0, 1, 0); PG8_SCHED; PG8_LDA(At, 1, 0); PG8_STAGE(PG8_SA(0, 1), a2 + hstep, voffA);
            PG8_WAIT_L(8); PG8_BAR; PG8_WAIT_L(0); PG8_MMA(0, 0, At, B0); PG8_BAR; PG8_SCHED;
            PG8_LDB(B1, 1, 1); PG8_STAGE(PG8_SB(1, 0), b3, voffB);
            PG8_BAR; PG8_WAIT_L(0); PG8_MMA(0, 1, At, B1); PG8_BAR;
            PG8_LDA(At, 1, 1); PG8_STAGE(PG8_SA(1, 0), a3, voffA);
            PG8_BAR; PG8_WAIT_L(0); PG8_MMA(1, 0, At, B0); PG8_BAR; PG8_SCHED;
            PG8_STAGE(PG8_SB(1, 1), b3 + hstep, voffB);
            PG8_WAIT_V(6); PG8_BAR; PG8_MMA(1, 1, At, B1); PG8_BAR;
            }
        }
        if constexpr (ALIGN_EPI) { if (wr == 0) PG8_BAR; }
        if constexpr (!Epi::AFTER_DRAIN) { E(acc, cur, wr, wc, fr, fq); S.done(cur); }
        if (!has_next) break;
#pragma unroll
        for (int a = 0; a < 2; ++a)
#pragma unroll
            for (int b = 0; b < 2; ++b)
#pragma unroll
                for (int m = 0; m < 4; ++m)
#pragma unroll
                    for (int n = 0; n < 2; ++n) acc[a][b][m][n] = (f32x4){0.f, 0.f, 0.f, 0.f};
        cur = nxt; cA = nA; cB = nB; ++ui;
        if constexpr (ALIGN_EPI) { if (wr == 1) PG8_BAR; }
    }
    PG8_WAIT_V(0);
    if constexpr (!ALIGN_EPI) { if (wr == 0) PG8_BAR; }
    PG8_BAR;
    if constexpr (Epi::AFTER_DRAIN) { E.fused(acc, cur, wr, wc, fr, fq, lds, wid, lane); S.done(cur); }
#undef PG8_SA
#undef PG8_SB
#undef PG8_STAGE
#undef PG8_LDA
#undef PG8_LDB
#undef PG8_MMA
#undef PG8_WAIT_V
#undef PG8_WAIT_L
#undef PG8_BAR
#undef PG8_SCHED
}
}
#include <hip/hip_bf16.h>
namespace attn_body {
using bf16=__hip_bfloat16;
using bf16x8=__attribute__((ext_vector_type(8)))short;
using s16x4=__attribute__((ext_vector_type(4)))short;
using f32x16=__attribute__((ext_vector_type(16)))float;
using u32x4=__attribute__((ext_vector_type(4)))unsigned;
constexpr int BATCH=4,NHEAD=16,SEQ=4096,D=64,DM=NHEAD*D,OPITCH=2048;
constexpr int NW=8,QBLK=32,QB=QBLK*NW,KVBLK=64,NQB=SEQ/QB;
constexpr int ATTN_PITCH=DM, ATTN_UNIT_ROWS=QB;
__device__ __forceinline__ int crow(int r,int hi){return (r&3)+8*(r>>2)+4*hi;}
#define SBAR() __builtin_amdgcn_sched_barrier(0)
__device__ __forceinline__ void cmask(f32x16&p0,f32x16&p1,int jb,int qrel,int hi){
  const float NEG=-INFINITY; int kb=64*jb+4*hi;
  #pragma unroll
  for(int r=0;r<16;++r){int kv=kb+(r&3)+8*(r>>2); if(kv>qrel)p0[r]=NEG; if(kv+32>qrel)p1[r]=NEG;}
}

constexpr int NSLOT=3, SLOTB=8192;
constexpr int LDS_K=0, LDS_V=NSLOT*SLOTB, LDS_WS=2*NSLOT*SLOTB, LDS_OST=LDS_WS+NW*64*4, LDS_BYTES=LDS_OST+NW*4096, LDS_NB=LDS_BYTES, LDS_NBW=LDS_NB+SEQ*4, LDS_TOTAL=LDS_NBW+64;
constexpr float C2=0.125f*1.4426950408889634f;
__device__ __forceinline__ void glds16(const void*gsrc,unsigned lds_dst){unsigned keep;
  asm volatile("s_mov_b32 %0, m0\n\ts_mov_b32 m0, %2\n\ts_nop 0\n\tglobal_load_lds_dwordx4 %1, off\n\ts_mov_b32 m0, %0":"=&s"(keep):"v"(gsrc),"s"(lds_dst):"memory");}
__device__ __forceinline__ float max3f(float a,float b,float c){float r;asm("v_max3_f32 %0, %1, %2, %3":"=v"(r):"v"(a),"v"(b),"v"(c));return r;}
__device__ __forceinline__ float max2f(float a,float b){float r;asm("v_max_f32_e32 %0, %1, %2":"=v"(r):"v"(a),"v"(b));return r;}
__device__ __forceinline__ float fadd_s(float a,float b){float r;asm("v_add_f32_e32 %0, %1, %2":"=v"(r):"v"(a),"v"(b));return r;}
__device__ __forceinline__ float fsub_s(float a,float b){float r;asm("v_sub_f32_e32 %0, %1, %2":"=v"(r):"v"(a),"v"(b));return r;}
typedef float f32x2_t __attribute__((ext_vector_type(2))); typedef __bf16 bf16x2_t __attribute__((ext_vector_type(2)));
__device__ __forceinline__ unsigned cvtpk_s(float lo,float hi){f32x2_t v={lo,hi};bf16x2_t b=__builtin_convertvector(v,bf16x2_t);return __builtin_bit_cast(unsigned,b);}
#define WAIT_BAR(N) asm volatile("s_waitcnt vmcnt(" #N ") lgkmcnt(0)\n\ts_barrier":::"memory")

__device__ __forceinline__ void qkt(f32x16&p0,f32x16&p1,const char*Kslot,const bf16x8*qr,int r32,int hi){
  const char*kb=Kslot+hi*1024+r32*16;
  #pragma unroll
  for(int d0=0;d0<4;++d0){
    const bf16x8 b0=*reinterpret_cast<const bf16x8*>(kb+d0*2048);
    const bf16x8 b1=*reinterpret_cast<const bf16x8*>(kb+d0*2048+512);
    p0=__builtin_amdgcn_mfma_f32_32x32x16_bf16(b0,qr[d0],p0,0,0,0);p1=__builtin_amdgcn_mfma_f32_32x32x16_bf16(b1,qr[d0],p1,0,0,0);}
}
typedef __attribute__((address_space(3))) const char* lds_cptr;
typedef short v4i16_t __attribute__((ext_vector_type(4)));
__device__ __forceinline__ void kload8(bf16x8*kf,lds_cptr kp){
  kf[0]=*(const __attribute__((address_space(3))) bf16x8*)(kp);      kf[1]=*(const __attribute__((address_space(3))) bf16x8*)(kp+512);
  kf[2]=*(const __attribute__((address_space(3))) bf16x8*)(kp+2048); kf[3]=*(const __attribute__((address_space(3))) bf16x8*)(kp+2560);
  kf[4]=*(const __attribute__((address_space(3))) bf16x8*)(kp+4096); kf[5]=*(const __attribute__((address_space(3))) bf16x8*)(kp+4608);
  kf[6]=*(const __attribute__((address_space(3))) bf16x8*)(kp+6144); kf[7]=*(const __attribute__((address_space(3))) bf16x8*)(kp+6656);
}
__device__ __forceinline__ void kload2(bf16x8*kf,lds_cptr kp,int j){ kf[2*j]=*(const __attribute__((address_space(3))) bf16x8*)(kp+j*2048); kf[2*j+1]=*(const __attribute__((address_space(3))) bf16x8*)(kp+j*2048+512); }
__device__ __forceinline__ s16x4 vtr(lds_cptr p){ return __builtin_bit_cast(s16x4,__builtin_amdgcn_ds_read_tr16_b64_v4i16((__attribute__((address_space(3))) v4i16_t*)p)); }
__device__ __forceinline__ float rowmax(const f32x16&p0,const f32x16&p1){
  float a=max3f(p0[0],p0[1],p1[0]),b=max3f(p0[2],p0[3],p1[1]);a=max3f(a,p1[2],p1[3]);
  #pragma unroll
  for(int r=4;r<16;r+=4){a=max3f(a,p0[r],p0[r+1]);b=max3f(b,p0[r+2],p0[r+3]);a=max3f(a,p1[r],p1[r+1]);b=max3f(b,p1[r+2],p1[r+3]);}
  const float m=max2f(a,b);
  auto rr=__builtin_amdgcn_permlane32_swap(__float_as_uint(m),__float_as_uint(m),false,false);
  return max2f(__uint_as_float(rr[0]),__uint_as_float(rr[1]));
}
__device__ __forceinline__ void pv(f32x16*o,int vb,bf16x8 pa0,bf16x8 pa1,bf16x8 pa2,bf16x8 pa3){
  #pragma unroll
  for(int d0=0;d0<2;++d0){s16x4 lo[4],hi[4];
    #pragma unroll
    for(int ks=0;ks<4;++ks){
      asm volatile("ds_read_b64_tr_b16 %0,%1 offset:%c2":"=&v"(lo[ks]):"v"(vb),"i"(d0*4096+ks*1024):"memory");
      asm volatile("ds_read_b64_tr_b16 %0,%1 offset:%c2":"=&v"(hi[ks]):"v"(vb),"i"(d0*4096+ks*1024+512):"memory");}
    asm volatile("s_waitcnt lgkmcnt(0)":::"memory");SBAR();
    #define PK(k) (bf16x8){lo[k][0],lo[k][1],lo[k][2],lo[k][3],hi[k][0],hi[k][1],hi[k][2],hi[k][3]}
    o[d0]=__builtin_amdgcn_mfma_f32_32x32x16_bf16(pa0,PK(0),o[d0],0,0,0);
    o[d0]=__builtin_amdgcn_mfma_f32_32x32x16_bf16(pa1,PK(1),o[d0],0,0,0);
    o[d0]=__builtin_amdgcn_mfma_f32_32x32x16_bf16(pa2,PK(2),o[d0],0,0,0);
    o[d0]=__builtin_amdgcn_mfma_f32_32x32x16_bf16(pa3,PK(3),o[d0],0,0,0);
    #undef PK
  }
}

#ifndef ATTN_STORE16
#define ATTN_STORE16(p,v) (*(u32x4*)(p)=(v))
#endif
template<int THRL> __device__ __forceinline__ void attn_unit(int b,int h,int qb,const bf16*Q,const bf16*__restrict__ K,const bf16*__restrict__ V,const bf16*__restrict__ Gt,bf16*O,char*shm,const int tid,const int t0){
  const int lane=tid&63,r32=lane&31,hi=lane>>5; const int wid=__builtin_amdgcn_readfirstlane(tid>>6);
  const long rowbase=(long)b*SEQ; const int q0=qb*QB;
  const bf16*Qw=Q+(rowbase+q0+wid*QBLK)*DM+h*D;
  const bf16*Kh=K+(rowbase+(long)t0*KVBLK)*DM+h*D,*Vh=V+(rowbase+(long)t0*KVBLK)*DM+h*D;
  const unsigned lds0=(unsigned)(uintptr_t)shm;
  float*wsf=(float*)(shm+LDS_WS)+wid*64;
  const bf16*ksrc=Kh+(long)lane*DM+wid*8;
  const bf16*vsrc=Vh+(long)(16*(wid&3)+(lane>>2))*DM+(wid>>2)*32+(lane&3)*8;
  const unsigned kdst=lds0+LDS_K+wid*1024, vdst=lds0+LDS_V+wid*1024;
  #define DMA_K(t,slot) glds16(ksrc+(long)(t)*KVBLK*DM,(unsigned)__builtin_amdgcn_readfirstlane(kdst+(slot)))
  #define DMA_V(t,slot) glds16(vsrc+(long)(t)*KVBLK*DM,(unsigned)__builtin_amdgcn_readfirstlane(vdst+(slot)))
  const int vb0=(int)(lds0+LDS_V)+((lane>>4)&1)*32+(lane&3)*8+(4*hi+((lane&15)>>2))*64;
  const char*Kbase=shm+LDS_K; bf16x8 kf[8];
  const lds_cptr shm3=(lds_cptr)shm; const lds_cptr kp0=shm3+LDS_K+hi*1024+r32*16; const lds_cptr vp0=shm3+LDS_V+((lane>>4)&1)*32+(lane&3)*8+(4*hi+((lane&15)>>2))*64;
  const int NT=(q0+QB)/KVBLK-t0;
  DMA_K(0,0);DMA_V(0,0);DMA_K(1,SLOTB);
  bf16x8 qr[4];
  #pragma unroll
  for(int d0=0;d0<4;++d0)qr[d0]=*reinterpret_cast<const bf16x8*>(&Qw[(long)r32*DM+d0*16+hi*8]);
  float mhat=0.f,l_reg=0.f;f32x16 o[2];o[0]=f32x16{};o[1]=f32x16{};
  typedef __attribute__((address_space(3))) const float* lds_fptr; typedef float f32x4_t __attribute__((ext_vector_type(4)));
  const lds_fptr nbp0=(lds_fptr)(shm3+LDS_NB)+4*hi+t0*KVBLK;
  #define NBLOAD(C0,C1,t) do{ const lds_fptr nbp_=nbp0+(t)*KVBLK; \
    _Pragma("unroll") for(int g_=0;g_<4;++g_){ const f32x4_t a_=*(const __attribute__((address_space(3))) f32x4_t*)(nbp_+8*g_); const f32x4_t b_=*(const __attribute__((address_space(3))) f32x4_t*)(nbp_+32+8*g_); \
      C0[4*g_]=a_[0];C0[4*g_+1]=a_[1];C0[4*g_+2]=a_[2];C0[4*g_+3]=a_[3]; C1[4*g_]=b_[0];C1[4*g_+1]=b_[1];C1[4*g_+2]=b_[2];C1[4*g_+3]=b_[3]; } }while(0)
  #define CINIT(C0,C1,t) do{ const lds_fptr nbp_=nbp0+(t)*KVBLK; const float nm_=-mhat; \
    _Pragma("unroll") for(int g_=0;g_<4;++g_){ const f32x4_t a_=*(const __attribute__((address_space(3))) f32x4_t*)(nbp_+8*g_); const f32x4_t b_=*(const __attribute__((address_space(3))) f32x4_t*)(nbp_+32+8*g_); \
      C0[4*g_]=a_[0]+nm_;C0[4*g_+1]=a_[1]+nm_;C0[4*g_+2]=a_[2]+nm_;C0[4*g_+3]=a_[3]+nm_; C1[4*g_]=b_[0]+nm_;C1[4*g_+1]=b_[1]+nm_;C1[4*g_+2]=b_[2]+nm_;C1[4*g_+3]=b_[3]+nm_; } }while(0)
  const int qrel=wid*QBLK+r32;
  #define CMASK(P0,P1,t) do{int jb_=(t)-(NT-4); if(jb_>=0)cmask(P0,P1,jb_,qrel,hi);}while(0)
  bool resc=false;
  #define START(P0,P1) do{ const float rm=rowmax(P0,P1); resc=false; \
    { const float dl=rm; mhat=fadd_s(mhat,dl); \
      _Pragma("unroll") for(int r=0;r<16;++r){P0[r]=fsub_s(P0[r],dl);P1[r]=fsub_s(P1[r],dl);} } \
    _Pragma("unroll") for(int r=0;r<16;++r)P0[r]=__builtin_amdgcn_exp2f(P0[r]); }while(0)
  #define RESC() do{ if(resc){ asm volatile("s_waitcnt lgkmcnt(0)":::"memory"); \
      _Pragma("unroll") for(int d_=0;d_<2;++d_) _Pragma("unroll") for(int r=0;r<16;++r)o[d_][r]*=wsf[crow(r,hi)]; } }while(0)
  f32x16 pA0,pA1,pB0,pB1;
  int sl_prev=0,sl_cur=0,sl_next=SLOTB;
  #define ROT() do{sl_prev=sl_cur;sl_cur=sl_next;sl_next=(sl_next==(NSLOT-1)*SLOTB)?0:sl_next+SLOTB;}while(0)
  DMA_K(2,2*SLOTB);
  WAIT_BAR(3);
  CINIT(pA0,pA1,0); qkt(pA0,pA1,Kbase,qr,r32,hi);asm volatile("s_nop 15\n\ts_nop 7":"+v"(pA0),"+v"(pA1));CMASK(pA0,pA1,0);
  START(pA0,pA1);
  CINIT(pB0,pB1,1);
  _Pragma("unroll") for(int r=0;r<16;++r)pA1[r]=__builtin_amdgcn_exp2f(pA1[r]);
  WAIT_BAR(0);
  DMA_K(3,0);DMA_V(1,SLOTB);
  ROT();
  kload8(kf,kp0+sl_cur);
  WAIT_BAR(2);
  s16x4 vlo[8],vhi[8]; u32x4 pw0,pw1,pw2,pw3;
  #define PKW(P,B) cvtpk_s(P[B],P[B+1])
  #define PAF(k) __builtin_bit_cast(bf16x8,pw##k)
  #define VFR(i) (bf16x8){vlo[i][0],vlo[i][1],vlo[i][2],vlo[i][3],vhi[i][0],vhi[i][1],vhi[i][2],vhi[i][3]}
  #define PIN(x) asm volatile("":"+v"(x))
  #define MX3(a,b,c) __builtin_fmaxf(__builtin_fmaxf((a),(b)),(c))
  #define GAPA(MF,A0,A1,A2,A3,W0,W1,PW) do{ MF; sacc+=A0; sacc+=A1; sacc+=A2; sacc+=A3; PIN(sacc); W0; W1; PIN(PW); SBAR(); }while(0)
  #define EX(v) __builtin_amdgcn_exp2f(v)
  #define GAPB(MF,X,B,Y) do{ MF; X[B]=EX(X[B]); X[B+1]=EX(X[B+1]); X[B+2]=EX(X[B+2]); X[B+3]=EX(X[B+3]); Y[B]+=nmn_; Y[B+1]+=nmn_; Y[B+2]+=nmn_; Y[B+3]+=nmn_; PIN(X); PIN(Y); SBAR(); }while(0)
  #define VRD(i) do{ vlo[i]=vtr(vp_+(((i)>>2)*4096+((i)&3)*1024)); vhi[i]=vtr(vp_+(((i)>>2)*4096+((i)&3)*1024+512)); }while(0)
  #define KRD(G,j) do{ if(G){ kload2(kf,kp0+sl_next,j); SBAR(); } }while(0)
  #define STEP(C0,C1,P0,P1,t,GK,GV,GL) do{ SBAR(); \
    const lds_cptr vp_=vp0+sl_prev; \
    VRD(0); SBAR(); float sacc=(P0[0]+P0[1]); \
    GAPA(C0=__builtin_amdgcn_mfma_f32_32x32x16_bf16(kf[0],qr[0],C0,0,0,0), P0[2],P0[3],P0[4],P0[5],     pw0[0]=PKW(P0,0), pw0[1]=PKW(P0,2), pw0); \
    VRD(4); SBAR(); GAPA(C1=__builtin_amdgcn_mfma_f32_32x32x16_bf16(kf[1],qr[0],C1,0,0,0), P0[6],P0[7],P0[8],P0[9],     pw0[2]=PKW(P0,4), pw0[3]=PKW(P0,6), pw0); \
    VRD(1); SBAR(); GAPA(C0=__builtin_amdgcn_mfma_f32_32x32x16_bf16(kf[2],qr[1],C0,0,0,0),   P0[10],P0[11],P0[12],P0[13], pw1[0]=PKW(P0,8), pw1[1]=PKW(P0,10), pw1); \
    VRD(5); SBAR(); GAPA(C1=__builtin_amdgcn_mfma_f32_32x32x16_bf16(kf[3],qr[1],C1,0,0,0),   P0[14],P0[15],P1[0],P1[1],   pw1[2]=PKW(P0,12),pw1[3]=PKW(P0,14), pw1); \
    VRD(2); SBAR(); GAPA(C0=__builtin_amdgcn_mfma_f32_32x32x16_bf16(kf[4],qr[2],C0,0,0,0),   P1[2],P1[3],P1[4],P1[5],     pw2[0]=PKW(P1,0), pw2[1]=PKW(P1,2), pw2); \
    VRD(6); SBAR(); GAPA(C1=__builtin_amdgcn_mfma_f32_32x32x16_bf16(kf[5],qr[2],C1,0,0,0),   P1[6],P1[7],P1[8],P1[9],     pw2[2]=PKW(P1,4), pw2[3]=PKW(P1,6), pw2); \
    VRD(3); SBAR(); GAPA(C0=__builtin_amdgcn_mfma_f32_32x32x16_bf16(kf[6],qr[3],C0,0,0,0),   P1[10],P1[11],P1[12],P1[13], pw3[0]=PKW(P1,8), pw3[1]=PKW(P1,10), pw3); \
    VRD(7); SBAR(); GAPA(C1=__builtin_amdgcn_mfma_f32_32x32x16_bf16(kf[7],qr[3],C1,0,0,0),   P1[14],P1[15],0.f,0.f,       pw3[2]=PKW(P1,12),pw3[3]=PKW(P1,14), pw3); \
    l_reg+=sacc; \
    if(GK){DMA_K((t)+3,sl_cur);} if(GV){DMA_V((t)+1,sl_next);} \
    CMASK(C0,C1,t); \
    { float a=MX3(C0[0],C0[1],C1[0]),b=MX3(C0[2],C0[3],C1[1]); a=MX3(a,C1[2],C1[3]); \
      _Pragma("unroll") for(int r=4;r<16;r+=4){a=MX3(a,C0[r],C0[r+1]);b=MX3(b,C0[r+2],C0[r+3]);a=MX3(a,C1[r],C1[r+1]);b=MX3(b,C1[r+2],C1[r+3]);} \
      float rm=__builtin_fmaxf(a,b); { auto rr=__builtin_amdgcn_permlane32_swap(__float_as_uint(rm),__float_as_uint(rm),false,false); rm=__builtin_fmaxf(__uint_as_float(rr[0]),__uint_as_float(rr[1])); } \
      resc=false; \
      if(__builtin_expect(__any(rm>(float)THRL),0)){ const float dl=__builtin_fmaxf(rm,0.f); mhat+=dl; \
        _Pragma("unroll") for(int r=0;r<16;++r){C0[r]-=dl;C1[r]-=dl;} \
        const float f=__builtin_amdgcn_exp2f(-dl); l_reg*=f; if(hi==0)wsf[r32]=f; resc=true; } } \
    const float nmn_=-mhat; if(GL){ NBLOAD(P0,P1,(t)+1); } \
    SBAR(); \
    GAPB(o[0]=__builtin_amdgcn_mfma_f32_32x32x16_bf16(PAF(0),VFR(0),o[0],0,0,0), C0,0,P0); \
    GAPB(o[1]=__builtin_amdgcn_mfma_f32_32x32x16_bf16(PAF(0),VFR(4),o[1],0,0,0), C0,4,P0); \
    KRD(GL,0); GAPB(o[0]=__builtin_amdgcn_mfma_f32_32x32x16_bf16(PAF(1),VFR(1),o[0],0,0,0), C0,8,P0); \
    KRD(GL,1); GAPB(o[1]=__builtin_amdgcn_mfma_f32_32x32x16_bf16(PAF(1),VFR(5),o[1],0,0,0), C0,12,P0); \
    KRD(GL,2); GAPB(o[0]=__builtin_amdgcn_mfma_f32_32x32x16_bf16(PAF(2),VFR(2),o[0],0,0,0), C1,0,P1); \
    KRD(GL,3); GAPB(o[1]=__builtin_amdgcn_mfma_f32_32x32x16_bf16(PAF(2),VFR(6),o[1],0,0,0), C1,4,P1); \
    GAPB(o[0]=__builtin_amdgcn_mfma_f32_32x32x16_bf16(PAF(3),VFR(3),o[0],0,0,0), C1,8,P1); \
    GAPB(o[1]=__builtin_amdgcn_mfma_f32_32x32x16_bf16(PAF(3),VFR(7),o[1],0,0,0), C1,12,P1); \
    }while(0)
  int t=1;
  #undef CMASK
  #define CMASK(P0,P1,t) do{}while(0)
  for(;t+5<NT;t+=2){
    STEP(pB0,pB1,pA0,pA1,t,true,true,true);     WAIT_BAR(2); RESC(); ROT();
    STEP(pA0,pA1,pB0,pB1,t+1,true,true,true);   WAIT_BAR(2); RESC(); ROT();
  }
  #undef CMASK
  #define CMASK(P0,P1,t) do{int jb_=(t)-(NT-4); if(jb_>=0)cmask(P0,P1,jb_,qrel,hi);}while(0)
  #define ENDW(tt) do{ if((tt)+3<NT){WAIT_BAR(2);} else if((tt)+2<NT){WAIT_BAR(1);} else {WAIT_BAR(0);} }while(0)
  for(;t+1<NT;t+=2){
    STEP(pB0,pB1,pA0,pA1,t,(t+3<NT),(t+1<NT),(t+1<NT));       ENDW(t);   RESC(); ROT();
    STEP(pA0,pA1,pB0,pB1,t+1,(t+4<NT),(t+2<NT),(t+2<NT));     ENDW(t+1); RESC(); ROT();
  }
  STEP(pB0,pB1,pA0,pA1,NT-1,false,false,false); RESC();
  { float sacc=pB0[0]+pB0[1]; _Pragma("unroll") for(int r=2;r<16;++r)sacc+=pB0[r]; _Pragma("unroll") for(int r=0;r<16;++r)sacc+=pB1[r]; l_reg+=sacc;
    pw0=(u32x4){PKW(pB0,0),PKW(pB0,2),PKW(pB0,4),PKW(pB0,6)};pw1=(u32x4){PKW(pB0,8),PKW(pB0,10),PKW(pB0,12),PKW(pB0,14)};pw2=(u32x4){PKW(pB1,0),PKW(pB1,2),PKW(pB1,4),PKW(pB1,6)};pw3=(u32x4){PKW(pB1,8),PKW(pB1,10),PKW(pB1,12),PKW(pB1,14)};
    SBAR(); pv(o,vb0+sl_cur,PAF(0),PAF(1),PAF(2),PAF(3)); }
  #undef PKW
  #undef PAF
  #undef VFR
  #undef PIN
  #undef MX3
  #undef GAPA
  #undef GAPB
  #undef EX
  #undef VRD
  #undef KRD
  #undef STEP
  #undef ENDW
  {auto rr=__builtin_amdgcn_permlane32_swap(__float_as_uint(l_reg),__float_as_uint(l_reg),false,false);l_reg=__uint_as_float(rr[0])+__uint_as_float(rr[1]);}
  if(hi==0)wsf[32+r32]=l_reg;asm volatile("s_waitcnt lgkmcnt(0)":::"memory");
  float rli[16];
  #pragma unroll
  for(int r=0;r<16;++r)rli[r]=__builtin_amdgcn_rcpf(wsf[32+crow(r,hi)]);
  bf16*Ow=O+(rowbase+q0+wid*QBLK)*OPITCH+h*D; const bf16*Gw=Gt+(rowbase+q0+wid*QBLK)*DM+h*D;
  { bf16*stg=(bf16*)(shm+LDS_OST)+wid*2048;
    #pragma unroll
    for(int r=0;r<16;++r){const int orow=crow(r,hi);
      #pragma unroll
      for(int d0=0;d0<2;++d0)stg[orow*64+d0*32+r32]=__float2bfloat16(o[d0][r]*rli[r]);}
    asm volatile("s_waitcnt lgkmcnt(0)":::"memory");
    #pragma unroll
    for(int i=0;i<4;++i){const int row=i*8+(lane>>3),ch=lane&7; const u32x4 v=*(const u32x4*)(stg+row*64+ch*8); const u32x4 gv=*(const u32x4*)(Gw+(long)row*DM+ch*8); u32x4 w;
      #pragma unroll
      for(int e=0;e<4;++e){ const float lo=__uint_as_float(v[e]<<16)*__uint_as_float(gv[e]<<16), hh=__uint_as_float(v[e]&0xffff0000u)*__uint_as_float(gv[e]&0xffff0000u); w[e]=cvtpk_s(lo,hh); }
      ATTN_STORE16(Ow+(long)row*OPITCH+ch*8,w);} }
  asm volatile("s_waitcnt lgkmcnt(0)\n\ts_barrier":::"memory");
  #undef DMA_K
  #undef DMA_V
  #undef CMASK
  #undef START
  #undef RESC
  #undef CINIT
  #undef NBLOAD
  #undef ROT
}
constexpr int ATTN_LDS_BYTES=LDS_TOTAL;
struct AttnTensors { const bf16* Q; long strideZ; long offO; long offNB; };
struct AttnUnit { int bh; int qb; };
struct StaticOrder {
  int vcu;
  __device__ __forceinline__ explicit StaticOrder(int grid,int block):vcu((grid%8==0)?(block%8)*(grid/8)+block/8:block){}
  __device__ __forceinline__ bool next(int i,AttnUnit&u)const{ if(i>=4)return false; const int s=vcu&3; u.bh=vcu>>2; u.qb=(i==0)?15-s:(i==1)?8+s:(i==2)?7-s:s; return true; }
};
template<int THRL=8> __device__ __forceinline__ void attn_phase(char*lds,const AttnTensors&T,int grid,int block,const int tid,unsigned*qctr,const unsigned*kn2){
  const int vc0=((grid%8==0)?(block%8)*(grid/8)+block/8:block); const int wid=tid>>6, lane=tid&63;
  float*wt=(float*)(lds+LDS_NBW);
  int u=vc0;
  while(u<BATCH*NHEAD*16){
    const int qb=15-(u>>6), bh=u&63, b=bh>>4, h=bh&15;
    int tid_u=tid; asm volatile("":"+v"(tid_u));
    { const float4*src=(const float4*)((const float*)((const char*)T.Q+T.offNB)+(size_t)bh*SEQ); float4*dst=(float4*)(lds+LDS_NB); const int n4=(qb+1)*(QB/4);
      unsigned pulled=0u; if(tid_u==0)pulled=atomicAdd(qctr,1u);
      const int x0=tid_u,x1=tid_u+NW*64; float4 nba=make_float4(0.f,0.f,0.f,0.f),nbb=nba; if(x0<n4)nba=src[x0]; if(x1<n4)nbb=src[x1];
      const bf16*Qw=T.Q+((long)b*SEQ+qb*QB+wid*QBLK+(lane&31))*DM+h*D+(lane>>5)*8; float sq=0.f;
      #pragma unroll
      for(int d0=0;d0<4;++d0){ const u32x4 v=*(const u32x4*)(Qw+d0*16);
        #pragma unroll
        for(int e=0;e<4;++e){ const float lo=__uint_as_float(v[e]<<16),hi2=__uint_as_float(v[e]&0xffff0000u); sq+=lo*lo+hi2*hi2; } }
      sq+=__shfl_xor(sq,32);
      #pragma unroll
      for(int o=1;o<32;o<<=1)sq=fmaxf(sq,__shfl_xor(sq,o));
      if(x0<n4)dst[x0]=nba; if(x1<n4)dst[x1]=nbb;
      if(lane==0)wt[wid]=sq;
      if(tid_u==0)wt[8]=__uint_as_float((unsigned)grid+pulled);
      __syncthreads(); }
    const int NTF=4*qb+4; int t0;
    { float q2=wt[0];
      #pragma unroll
      for(int w=1;w<8;++w)q2=fmaxf(q2,wt[w]);
      const float k2=__uint_as_float(kn2[bh*2])+__uint_as_float(kn2[bh*2+1]);
      const float TH=64.f+2.f*sqrtf(q2*k2)*1.001f;
      const float*nbl=(const float*)(lds+LDS_NB); const float nbq=nbl[qb*QB];
      const bool skip=(lane<NTF)&&(nbq-nbl[64*(lane<NTF?lane:0)+63]>TH);
      const unsigned long long m=__ballot(skip); const int ns=(~m==0ull)?64:__builtin_ctzll(~m);
      t0=ns&~1; if(t0>NTF-4)t0=NTF-4; t0=__builtin_amdgcn_readfirstlane(t0); }
    const int unext=(int)__float_as_uint(wt[8]);
    attn_unit<THRL>(b,h,qb,T.Q,T.Q+T.strideZ,T.Q+2*T.strideZ,T.Q+3*T.strideZ,(bf16*)((char*)T.Q+T.offO),lds,tid_u,t0);
    u=__builtin_amdgcn_readfirstlane(unext);
  }
}
#undef SBAR
#undef WAIT_BAR
}
constexpr int NB = 4, SEQ = 4096, DM = 2048, DEPTH = 2, M = NB * SEQ, DIN = 7184, NPAD = 7168, WA = 1024;
constexpr int NWAVES = 8, NTHR = 512;
constexpr float EPS = 1e-6f;
constexpr size_t MiB = 1u << 20;
constexpr size_t WS_MODP = 2 * MiB;
constexpr size_t WS_WS = 6 * MiB;
constexpr size_t WS_MODF = 5 * MiB;
constexpr size_t WS_LF = 7 * MiB;
constexpr size_t WS_WIN = 8 * MiB;
constexpr size_t WS_WOUT = 66 * MiB;
constexpr size_t WS_H = 82 * MiB;
constexpr size_t WS_Z = 146 * MiB;
constexpr size_t WS_Y = 370 * MiB;
constexpr size_t WS_STATP = 434 * MiB;
constexpr size_t WS_NB = 436 * MiB;
constexpr size_t WS_T0 = 438 * MiB;
constexpr size_t WS_END = 502 * MiB;
constexpr int MOD_KC = 16, MOD_KROWS = 128;
constexpr int LDS_PHASE = 147456, LDS_BYTES = LDS_PHASE + 256;
constexpr size_t WS_BAR = 0, BAR_ZERO_BYTES = 16384, WS_KN2 = 14336  , WS_QCTR = 15360  , WS_MCTR = 15424  , WS_TCTR = 15616  ;

#define LAS __attribute__((address_space(3)))
typedef unsigned short bf16;
typedef unsigned v4u __attribute__((ext_vector_type(4)));
typedef unsigned v2u __attribute__((ext_vector_type(2)));
typedef float f32x4 __attribute__((ext_vector_type(4)));
typedef float f32x16 __attribute__((ext_vector_type(16)));
typedef short bf16x8 __attribute__((ext_vector_type(8)));
__device__ __forceinline__ unsigned pk2(float lo, float hi) { typedef float f2 __attribute__((ext_vector_type(2))); typedef __bf16 b2 __attribute__((ext_vector_type(2))); f2 v = {lo, hi}; b2 b = __builtin_convertvector(v, b2); return __builtin_bit_cast(unsigned, b); }
typedef _Float16 h16x2 __attribute__((ext_vector_type(2))); typedef float f32x2h __attribute__((ext_vector_type(2)));
__device__ __forceinline__ unsigned pkh2(float lo, float hi) { f32x2h v = {lo, hi}; h16x2 h = __builtin_convertvector(v, h16x2); return __builtin_bit_cast(unsigned, h); }
__device__ __forceinline__ f32x2h uph2(unsigned u) { return __builtin_convertvector(__builtin_bit_cast(h16x2, u), f32x2h); }
__device__ __forceinline__ float bflo(unsigned u) { return __uint_as_float(u << 16); }
__device__ __forceinline__ float bfhi(unsigned u) { return __uint_as_float(u & 0xffff0000u); }
__device__ __forceinline__ float wave_sum(float v) {
#pragma unroll
    for (int o = 1; o < 64; o <<= 1) v += __shfl_xor(v, o);
    return v;
}

#define XB_TMO      128
#define XB_XCNT(j)  (256  + 64 * (j))
#define XB_XSUB(j)  (1280 + 64 * (j))
#define XB_XGEN(j)  (2304 + 64 * (j))
#define XB_TOP      3328
#define XB_TOPGEN   3392
#define XCD_BAR_WORDS 3456
#define XB_SPIN_CAP (1u << 18)

__device__ __forceinline__ unsigned xb_ld(unsigned* p)              { return __hip_atomic_load(p, __ATOMIC_RELAXED, __HIP_MEMORY_SCOPE_AGENT); }
__device__ __forceinline__ unsigned xb_add(unsigned* p, unsigned v) { return __hip_atomic_fetch_add(p, v, __ATOMIC_RELAXED, __HIP_MEMORY_SCOPE_AGENT); }
__device__ __forceinline__ unsigned xb_xcc_id() { return (unsigned)__builtin_amdgcn_s_getreg((3 << 11) | 20) & 0xFu; }
#define XB_SPIN(cond, bar) do { unsigned _sp = 0; while (cond) { __builtin_amdgcn_s_sleep(1); \
    if ((++_sp & 255u) == 0u) { if (xb_ld(&(bar)[XB_TMO])) break; if (_sp > XB_SPIN_CAP) { atomicAdd(&(bar)[XB_TMO], 1u); break; } } } } while (0)

struct XcdBarrier {
    unsigned* bar; unsigned x;
    volatile LAS unsigned* st;
};

__device__ __forceinline__ XcdBarrier xcd_barrier_post(unsigned* bar, volatile LAS unsigned* st) {
    XcdBarrier b; b.bar = bar; b.x = xb_xcc_id(); b.st = st;
    if (threadIdx.x == 0) (void)xb_add(&bar[XB_XCNT(b.x)], 1u);
    return b;
}
__device__ __forceinline__ void xcd_barrier_complete(unsigned* bar, unsigned x, unsigned& nloc, unsigned& nx) {
    const unsigned G = gridDim.x * gridDim.y * gridDim.z;
    unsigned sum, cnt, mine, sp = 0u;
    for (;;) {
        sum = 0u; cnt = 0u; mine = 0u;
#pragma unroll
        for (unsigned j = 0; j < 16; ++j) { const unsigned c = xb_ld(&bar[XB_XCNT(j)]); sum += c; cnt += (c > 0u) ? 1u : 0u; mine = (j == x) ? c : mine; }
        if (sum == G) break;
        __builtin_amdgcn_s_sleep(1);
        if ((++sp & 255u) == 0u) { if (xb_ld(&bar[XB_TMO])) break; if (sp > XB_SPIN_CAP) { atomicAdd(&bar[XB_TMO], 1u); break; } }
    }
    nloc = mine > 0u ? mine : 1u; nx = cnt > 0u ? cnt : 1u;
}

__device__ __forceinline__ void xcd_barrier(const XcdBarrier& b) {
    asm volatile("s_waitcnt vmcnt(0)" ::: "memory");
    __syncthreads();
    if (threadIdx.x == 0) {
        unsigned* bar = b.bar;
        __builtin_amdgcn_s_waitcnt(0);
        unsigned nloc = b.st[0], nx = b.st[1];
        if (nloc == 0u) { xcd_barrier_complete(bar, b.x, nloc, nx); b.st[0] = nloc; b.st[1] = nx; }
        const unsigned old = xb_add(&bar[XB_XSUB(b.x)], 1u);
        const unsigned gen = old / nloc;
        if (old + 1u == (gen + 1u) * nloc) {
            __builtin_amdgcn_fence(__ATOMIC_RELEASE, "agent");
            asm volatile("s_waitcnt vmcnt(0)" ::: "memory");
            const unsigned og = xb_add(&bar[XB_TOP], 1u);
            const unsigned tg = og / nx;
            if (og + 1u == (tg + 1u) * nx) xb_add(&bar[XB_TOPGEN], 1u);
            else XB_SPIN(xb_ld(&bar[XB_TOPGEN]) == tg, bar);
            __builtin_amdgcn_fence(__ATOMIC_ACQUIRE, "agent");
            xb_add(&bar[XB_XGEN(b.x)], 1u);
            asm volatile("s_waitcnt vmcnt(0)" ::: "memory");
        } else {
            XB_SPIN(xb_ld(&bar[XB_XGEN(b.x)]) == gen, bar);
            __builtin_amdgcn_fence(__ATOMIC_ACQUIRE, "agent");
            asm volatile("s_waitcnt vmcnt(0)" ::: "memory");
        }
    }
    __syncthreads();
}

struct Args { const float* in[13]; float* out; unsigned char* ws; int ph_lo, ph_hi; };

__device__ __forceinline__ void p0_transpose_item(const float* W, int K, int N, int ldw, bf16* WT, LAS float* scr, int item, int lane) {
    const int nblk = N / 32, kb = item / nblk, nb = item % nblk, k0 = 64 * kb, n0 = 32 * nb;
    f32x4 tv[8];
#pragma unroll
    for (int i = 0; i < 8; ++i) tv[i] = __builtin_nontemporal_load((const f32x4*)(W + (size_t)(k0 + 8 * i + (lane >> 3)) * ldw + n0 + 4 * (lane & 7)));
#pragma unroll
    for (int i = 0; i < 8; ++i) { LAS float* d = scr + (8 * i + (lane >> 3)) * 33 + 4 * (lane & 7); d[0] = tv[i][0]; d[1] = tv[i][1]; d[2] = tv[i][2]; d[3] = tv[i][3]; }
    asm volatile("s_waitcnt lgkmcnt(0)" ::: "memory");
    const int c = lane & 7;
#pragma unroll
    for (int j = 0; j < 4; ++j) { const int n = (lane >> 3) + 8 * j; const LAS float* s = scr + (8 * c) * 33 + n;
        v4u o; o.x = pk2(s[0 * 33], s[1 * 33]); o.y = pk2(s[2 * 33], s[3 * 33]); o.z = pk2(s[4 * 33], s[5 * 33]); o.w = pk2(s[6 * 33], s[7 * 33]);
        *(v4u*)(WT + (size_t)(n0 + n) * K + k0 + 8 * c) = o; }
    asm volatile("s_waitcnt lgkmcnt(0)" ::: "memory");
}
__device__ __forceinline__ void p0_mod_item(const float* cin, const float* w_ada, const float* b_ada, float* modp, float* modf, unsigned* mctr, int idx, int lane) {
    const int l = idx / (24 * MOD_KC), r = idx % (24 * MOD_KC), cgp = r / MOD_KC, kc = r % MOD_KC;
    const float* W = w_ada + (size_t)l * DM * 6144 + (size_t)(kc * MOD_KROWS) * 6144 + cgp * 256 + lane * 4;
    f32x4 acc[4];
#pragma unroll
    for (int b = 0; b < 4; ++b) acc[b] = (f32x4){0.f, 0.f, 0.f, 0.f};
#pragma unroll
    for (int j = 0; j < MOD_KROWS / 64; ++j) {
        float sv[4];
#pragma unroll
        for (int b = 0; b < 4; ++b) { const float c = cin[b * DM + kc * MOD_KROWS + j * 64 + lane]; sv[b] = c / (1.0f + __expf(-c)); }
#pragma unroll 16
        for (int kk = 0; kk < 64; ++kk) { const f32x4 w = __builtin_nontemporal_load((const f32x4*)(W + (size_t)(j * 64 + kk) * 6144));
#pragma unroll
            for (int b = 0; b < 4; ++b) { const float s = __uint_as_float(__builtin_amdgcn_readlane(__float_as_uint(sv[b]), kk)); acc[b] += w * s; } }
    }
#pragma unroll
    for (int b = 0; b < 4; ++b) *(f32x4*)(modp + (((size_t)kc * 2 + l) * 4 + b) * 6144 + cgp * 256 + lane * 4) = acc[b];
}
__device__ __forceinline__ void mod_combine(const Args& a, int bx, int G, int tid) {
    const float* modp = (const float*)(a.ws + WS_MODP); float* modf = (float*)(a.ws + WS_MODF);
    for (int o = bx * NTHR + tid; o < 2 * 4 * 6144; o += G * NTHR) { const int l = o / (4 * 6144), b = (o / 6144) & 3, k = o % 6144;
        float sum = a.in[4][(size_t)l * 6144 + k];
#pragma unroll
        for (int kc = 0; kc < MOD_KC; ++kc) sum += modp[(((size_t)kc * 2 + l) * 4 + b) * 6144 + k];
        modf[o] = sum; }
}
__device__ __forceinline__ void p0_prologue(const Args& a, LAS unsigned char* lds, int vcu, int G, int wave, int lane, bool dup) {
    LAS float* scr = (LAS float*)(lds + wave * 16384);
    unsigned char* ws = a.ws;
    constexpr int I_MOD = 2 * 24 * MOD_KC, I_IN = (DM / 64) * (NPAD / 32), I_OUT = (DM / 64) * (DM / 32), I_WS = (2 * 8 * 128 * 128) / 512;
    constexpr int NCONV = 2 * I_IN + 2 * I_OUT + I_WS;
    if (wave == 0 && lane == 0) *(LAS unsigned*)(lds + 131072) = 0u;
    __syncthreads();
    if (!(dup && PROBE_PART == 2)) for (int m = vcu + G * wave; m < I_MOD; m += G * NWAVES) p0_mod_item(a.in[1], a.in[3], a.in[4], (float*)(ws + WS_MODP), (float*)(ws + WS_MODF), (unsigned*)(ws + WS_MCTR), m, lane);
    LAS unsigned* lctr = (LAS unsigned*)(lds + 131072);
    if (!(dup && PROBE_PART == 1)) for (;;) {
        unsigned itu = 0u; if (lane == 0) itu = __hip_atomic_fetch_add(lctr, 1u, __ATOMIC_RELAXED, __HIP_MEMORY_SCOPE_WORKGROUP);
        int r = vcu + G * __builtin_amdgcn_readfirstlane((int)itu);
        if (r >= NCONV) break;
        if (r < 2 * I_IN) { const int l = r / I_IN; p0_transpose_item(a.in[5] + (size_t)l * DM * DIN, DM, NPAD, DIN, (bf16*)(ws + WS_WIN) + (size_t)l * NPAD * DM, scr, r % I_IN, lane); continue; } r -= 2 * I_IN;
        if (r < 2 * I_OUT) { const int l = r / I_OUT; p0_transpose_item(a.in[11] + (size_t)l * DM * DM, DM, DM, DM, (bf16*)(ws + WS_WOUT) + (size_t)l * DM * DM, scr, r % I_OUT, lane); continue; } r -= 2 * I_OUT;
        { const float* src = a.in[8] + (size_t)r * 512 + lane * 8; const f32x4 x0 = *(const f32x4*)src, x1 = *(const f32x4*)(src + 4);
          v4u o; o.x = pk2(x0[0], x0[1]); o.y = pk2(x0[2], x0[3]); o.z = pk2(x1[0], x1[1]); o.w = pk2(x1[2], x1[3]);
          *(v4u*)((bf16*)(ws + WS_WS) + (size_t)r * 512 + lane * 8) = o; }
    }
}
__device__ __forceinline__ void p1_modnorm(const Args& a, LAS unsigned char* lds, int l, const float* xin, const bf16* T0, int bid, int G, int tid, int wave, int lane) {
    LAS float* gs = (LAS float*)lds; LAS float* sh = gs + DM;
    LAS unsigned char* WfT = lds + 16384; LAS unsigned char* hT = lds + 81920 + wave * 8192;
    const float* modf = (const float*)(a.ws + WS_MODF); const float* ng = a.in[2] + (size_t)l * DM;
    const float* wf_g = a.in[5] + (size_t)l * DM * DIN + 7168; const float* bfl = a.in[10] + l * 16;
    bf16* H = (bf16*)(a.ws + WS_H); float* LF = (float*)(a.ws + WS_LF);
    for (int k = tid; k < DM; k += NTHR) {
#pragma unroll
        for (int c = 0; c < 4; ++c) { const f32x4 x = *(const f32x4*)(wf_g + (size_t)k * DIN + 4 * c);
#pragma unroll
            for (int e = 0; e < 4; ++e) { const int n = 4 * c + e; *(LAS unsigned short*)(WfT + n * 4096 + ((((k >> 3) ^ n) & 255) << 4) + (k & 7) * 2) = (unsigned short)(pk2(x[e], 0.f) & 0xffffu); } } }
    const int mj = lane & 15, mq = lane >> 4;
    for (int rb = bid; rb < M / 64; rb += G) {
        const int b = rb / (SEQ / 64);
        for (int i = 0; i < DM / NTHR; ++i) { const int k = tid + NTHR * i; const float* p = modf + ((size_t)l * 4 + b) * 6144 + k;
            gs[k] = ng[k] * (1.0f + p[DM]); sh[k] = p[0]; }
        __syncthreads();
        const int rowb = rb * 64 + wave * 8;
        f32x4 v0[8], v1[8]; v2u tA[8], tB[8];
#define P1_LOADROWS(ROW) do { const f32x4* xr0 = (const f32x4*)(xin + (size_t)(ROW) * DM) + lane; const f32x4* xr1 = xr0 + DM / 4; \
          _Pragma("unroll") for (int j = 0; j < 8; ++j) { v0[j] = __builtin_nontemporal_load(xr0 + 64 * j); v1[j] = __builtin_nontemporal_load(xr1 + 64 * j); } \
          if (T0) { const v2u* t0p = (const v2u*)(T0 + (size_t)(ROW) * DM) + lane; const v2u* t1p = t0p + DM / 4; \
            _Pragma("unroll") for (int j = 0; j < 8; ++j) { tA[j] = t0p[64 * j]; tB[j] = t1p[64 * j]; } } } while (0)
        P1_LOADROWS(rowb);
        for (int rp = 0; rp < 4; ++rp) { const int row = rowb + 2 * rp;
            float ss0 = 0.f, ss1 = 0.f;
            if (T0) {
#pragma unroll
                for (int j = 0; j < 8; ++j) { v0[j] += (f32x4){bflo(tA[j].x), bfhi(tA[j].x), bflo(tA[j].y), bfhi(tA[j].y)}; v1[j] += (f32x4){bflo(tB[j].x), bfhi(tB[j].x), bflo(tB[j].y), bfhi(tB[j].y)}; }
                v2u* x0p = (v2u*)((bf16*)T0 + (size_t)row * DM) + lane; v2u* x1p = x0p + DM / 4;
#pragma unroll
                for (int j = 0; j < 8; ++j) { v2u wa, wb; wa.x = pkh2(v0[j][0], v0[j][1]); wa.y = pkh2(v0[j][2], v0[j][3]); wb.x = pkh2(v1[j][0], v1[j][1]); wb.y = pkh2(v1[j][2], v1[j][3]); x0p[64 * j] = wa; x1p[64 * j] = wb; } }
#pragma unroll
            for (int j = 0; j < 8; ++j) { ss0 += (v0[j][0] * v0[j][0] + v0[j][1] * v0[j][1]) + (v0[j][2] * v0[j][2] + v0[j][3] * v0[j][3]); ss1 += (v1[j][0] * v1[j][0] + v1[j][1] * v1[j][1]) + (v1[j][2] * v1[j][2] + v1[j][3] * v1[j][3]); }
            const float rstd0 = 1.0f / sqrtf(wave_sum(ss0) * (1.0f / DM) + EPS), rstd1 = 1.0f / sqrtf(wave_sum(ss1) * (1.0f / DM) + EPS);
            v2u* o0 = (v2u*)(H + (size_t)row * DM) + lane; v2u* o1 = o0 + DM / 4;
#pragma unroll
            for (int j = 0; j < 8; ++j) { const f32x4 gj = *(const LAS f32x4*)(gs + 4 * lane + 256 * j), sj = *(const LAS f32x4*)(sh + 4 * lane + 256 * j);
                const f32x4 y0 = v0[j] * rstd0 * gj + sj, y1 = v1[j] * rstd1 * gj + sj;
                v2u w0, w1; w0.x = pk2(y0[0], y0[1]); w0.y = pk2(y0[2], y0[3]); w1.x = pk2(y1[0], y1[1]); w1.y = pk2(y1[2], y1[3]);
                o0[64 * j] = w0; o1[64 * j] = w1;
                *(LAS v2u*)(hT + (4 * lane + 256 * j) * 2) = w0; *(LAS v2u*)(hT + 4096 + (4 * lane + 256 * j) * 2) = w1; }
            if (rp < 3) P1_LOADROWS(row + 2);
            f32x4 d0 = (f32x4){0.f, 0.f, 0.f, 0.f}, d1 = d0, d2 = d0, d3 = d0;
            const LAS unsigned char* ap = WfT + mj * 4096; const LAS unsigned char* bp = hT + (mj & 1) * 4096 + mq * 16;
#pragma unroll 4
            for (int st = 0; st < 64; st += 4) {
                const bf16x8 a0 = *(const LAS bf16x8*)(ap + ((((4 * st + mq) ^ mj) & 255) << 4)), b0 = *(const LAS bf16x8*)(bp + 64 * st);
                const bf16x8 a1 = *(const LAS bf16x8*)(ap + ((((4 * st + 4 + mq) ^ mj) & 255) << 4)), b1 = *(const LAS bf16x8*)(bp + 64 * st + 64);
                const bf16x8 a2 = *(const LAS bf16x8*)(ap + ((((4 * st + 8 + mq) ^ mj) & 255) << 4)), b2 = *(const LAS bf16x8*)(bp + 64 * st + 128);
                const bf16x8 a3 = *(const LAS bf16x8*)(ap + ((((4 * st + 12 + mq) ^ mj) & 255) << 4)), b3 = *(const LAS bf16x8*)(bp + 64 * st + 192);
                d0 = __builtin_amdgcn_mfma_f32_16x16x32_bf16(a0, b0, d0, 0, 0, 0); d1 = __builtin_amdgcn_mfma_f32_16x16x32_bf16(a1, b1, d1, 0, 0, 0);
                d2 = __builtin_amdgcn_mfma_f32_16x16x32_bf16(a2, b2, d2, 0, 0, 0); d3 = __builtin_amdgcn_mfma_f32_16x16x32_bf16(a3, b3, d3, 0, 0, 0); }
            const f32x4 d = (d0 + d1) + (d2 + d3);
            if (mj < 2) { const int rr = row + mj;
#pragma unroll
                for (int r = 0; r < 4; ++r) { const int head = 4 * mq + r; const float x = d[r] + bfl[head]; const float lf = fminf(x, 0.f) - log1pf(expf(-fabsf(x)));
                    LF[((size_t)(rr / SEQ) * 16 + head) * SEQ + (rr % SEQ)] = lf; } } }
        __syncthreads();
    }
}
__device__ __forceinline__ void p_final(const Args& a, int vcu, int G, int wave, int lane) {
    const f32x4* fg = (const f32x4*)a.in[12] + lane;
    f32x4 g4[8];
#pragma unroll
    for (int j = 0; j < 8; ++j) g4[j] = fg[64 * j];
    const bf16* T0 = (const bf16*)(a.ws + WS_T0); const bf16* T1 = (const bf16*)(a.ws + WS_H);
    for (int row = vcu * NWAVES + wave; row < M; row += G * NWAVES) {
        const v2u* t0p = (const v2u*)(T0 + (size_t)row * DM) + lane; const v2u* t1p = (const v2u*)(T1 + (size_t)row * DM) + lane;
        f32x4 v[8]; v2u ta[8], tb[8]; float ss = 0.f;
#pragma unroll
        for (int j = 0; j < 8; ++j) { ta[j] = __builtin_nontemporal_load(t0p + 64 * j); tb[j] = __builtin_nontemporal_load(t1p + 64 * j); }
        asm volatile("" : "+v"(ta[0]), "+v"(ta[1]), "+v"(ta[2]), "+v"(ta[3]), "+v"(ta[4]), "+v"(ta[5]), "+v"(ta[6]), "+v"(ta[7]),
                     "+v"(tb[0]), "+v"(tb[1]), "+v"(tb[2]), "+v"(tb[3]), "+v"(tb[4]), "+v"(tb[5]), "+v"(tb[6]), "+v"(tb[7]));
#pragma unroll
        for (int j = 0; j < 8; ++j) { const f32x2h a0 = uph2(ta[j].x), a1 = uph2(ta[j].y); v[j] = (f32x4){a0.x, a0.y, a1.x, a1.y} + (f32x4){bflo(tb[j].x), bfhi(tb[j].x), bflo(tb[j].y), bfhi(tb[j].y)}; }
#pragma unroll
        for (int j = 0; j < 8; ++j) ss += (v[j][0] * v[j][0] + v[j][1] * v[j][1]) + (v[j][2] * v[j][2] + v[j][3] * v[j][3]);
        const float rstd = 1.0f / sqrtf(wave_sum(ss) * (1.0f / DM) + EPS);
        f32x4* orow = (f32x4*)(a.out + (size_t)row * DM) + lane;
#pragma unroll
        for (int j = 0; j < 8; ++j) __builtin_nontemporal_store(v[j] * rstd * g4[j], orow + 64 * j);
    }
}
__device__ __forceinline__ void gmlp_phase(const Args& a, LAS unsigned char* lds, int l, int vcu, int G, int wave, int lane) {
    const bf16* U = (const bf16*)(a.ws + WS_Z); const bf16* V = U + (size_t)M * 1024; const bf16* GA = U + (size_t)2 * M * 1024;
    bf16* Y = (bf16*)(a.ws + WS_Y); const float* STATP = (const float*)(a.ws + WS_STATP);
    const bf16* Wsb = (const bf16*)(a.ws + WS_WS) + (size_t)l * 8 * 128 * 128;
    const float* bs = a.in[9] + (size_t)l * 8 * 128; const float* lng = a.in[6] + (size_t)l * WA; const float* lnb = a.in[7] + (size_t)l * WA;
    constexpr int LTP = 272;
    LAS unsigned char* LT = lds + wave * (64 * LTP);
    const int hi = lane >> 5, r32 = lane & 31;
    LAS float* lnL = (LAS float*)(lds + 8 * 64 * LTP);
    { const int t4 = (wave * 64 + lane) * 4; *(LAS f32x4*)(lnL + t4) = t4 < 1024 ? *(const f32x4*)(lng + t4) : *(const f32x4*)(lnb + t4 - 1024); }
    __syncthreads();
    for (int id = vcu * NWAVES + wave; id < 2048; id += G * NWAVES) {
        const int dh = id & 1, hd = (id >> 1) & 7, n = (id >> 4) & 31, b = id >> 9; const size_t R0 = (size_t)b * SEQ + (size_t)n * 128; const int cb = hd * 128 + dh * 64;
        const f32x4* sp = (const f32x4*)(STATP + (R0 + 2 * lane) * 32);
        const bf16* vp0 = V + (R0 + 2 * lane) * 1024 + cb; const bf16* vp1 = vp0 + 1024;
        f32x4 st[16]; v4u va[8], vb[8];
#pragma unroll
        for (int j = 0; j < 16; ++j) st[j] = sp[j];
#pragma unroll
        for (int c = 0; c < 8; ++c) { va[c] = *(const v4u*)(vp0 + 8 * c); vb[c] = *(const v4u*)(vp1 + 8 * c); }
        asm volatile("" : "+v"(st[0]), "+v"(st[1]), "+v"(st[2]), "+v"(st[3]), "+v"(st[4]), "+v"(st[5]), "+v"(st[6]), "+v"(st[7]), "+v"(st[8]), "+v"(st[9]), "+v"(st[10]), "+v"(st[11]), "+v"(st[12]), "+v"(st[13]), "+v"(st[14]), "+v"(st[15]));
        asm volatile("" : "+v"(va[0]), "+v"(va[1]), "+v"(va[2]), "+v"(va[3]), "+v"(va[4]), "+v"(va[5]), "+v"(va[6]), "+v"(va[7]), "+v"(vb[0]), "+v"(vb[1]), "+v"(vb[2]), "+v"(vb[3]), "+v"(vb[4]), "+v"(vb[5]), "+v"(vb[6]), "+v"(vb[7]));
        float mean0, rs0, mean1, rs1;
        { float s0 = 0.f, q0 = 0.f, s1 = 0.f, q1 = 0.f;
#pragma unroll
          for (int j = 0; j < 8; ++j) { const f32x4 x = st[j], y = st[8 + j]; s0 += x[0] + x[2]; q0 += x[1] + x[3]; s1 += y[0] + y[2]; q1 += y[1] + y[3]; }
          mean0 = s0 * (1.0f / 1024.0f); mean1 = s1 * (1.0f / 1024.0f);
          rs0 = 1.0f / sqrtf(fmaxf(q0 * (1.0f / 1024.0f) - mean0 * mean0, 0.f) + EPS); rs1 = 1.0f / sqrtf(fmaxf(q1 * (1.0f / 1024.0f) - mean1 * mean1, 0.f) + EPS); }
#pragma unroll
        for (int c = 0; c < 8; ++c) {
            const f32x4 ga = *(const LAS f32x4*)(lnL + cb + 8 * c), gb = *(const LAS f32x4*)(lnL + cb + 8 * c + 4), ba = *(const LAS f32x4*)(lnL + 1024 + cb + 8 * c), bb = *(const LAS f32x4*)(lnL + 1024 + cb + 8 * c + 4);
#pragma unroll
            for (int e = 0; e < 4; ++e) { const float gl = e < 2 ? ga[2 * e] : gb[2 * e - 4], gh = e < 2 ? ga[2 * e + 1] : gb[2 * e - 3], bl = e < 2 ? ba[2 * e] : bb[2 * e - 4], bh = e < 2 ? ba[2 * e + 1] : bb[2 * e - 3];
                const float x0 = (bflo(va[c][e]) - mean0) * rs0 * gl + bl, x1 = (bflo(vb[c][e]) - mean1) * rs1 * gl + bl;
                const float y0 = (bfhi(va[c][e]) - mean0) * rs0 * gh + bh, y1 = (bfhi(vb[c][e]) - mean1) * rs1 * gh + bh;
                const int d0 = 8 * c + 2 * e, d1 = d0 + 1; const int e0 = d0 & 31, e1 = d1 & 31;
                const int sl0 = 32 * (d0 >> 5) + 8 * ((e0 >> 2) & 3) + 4 * (e0 >> 4) + (e0 & 3), sl1 = 32 * (d1 >> 5) + 8 * ((e1 >> 2) & 3) + 4 * (e1 >> 4) + (e1 & 3);
                *(LAS unsigned*)(LT + sl0 * LTP + 4 * lane) = pk2(x0, x1);
                *(LAS unsigned*)(LT + sl1 * LTP + 4 * lane) = pk2(y0, y1); } }
        bf16x8 af[2][8];
#pragma unroll
        for (int dt = 0; dt < 2; ++dt)
#pragma unroll
            for (int kk = 0; kk < 8; ++kk) af[dt][kk] = *(const LAS bf16x8*)(LT + (32 * dt + r32) * LTP + (16 * kk + 8 * hi) * 2);
#pragma unroll
        for (int ps = 0; ps < 2; ++ps) {
            f32x16 acc[2][2];
            bf16x8 wfr[2][8];
#pragma unroll
            for (int t2 = 0; t2 < 2; ++t2) { const int tt = 2 * ps + t2; const bf16* Wrow = Wsb + ((size_t)hd * 128 + tt * 32 + r32) * 128 + 8 * hi;
#pragma unroll
                for (int kk = 0; kk < 2 * tt + 2; ++kk) wfr[t2][kk] = *(const bf16x8*)(Wrow + 16 * kk); }
#pragma unroll
            for (int t2 = 0; t2 < 2; ++t2) { const int tt = 2 * ps + t2; acc[0][t2] = f32x16{}; acc[1][t2] = f32x16{}; const int tl = tt * 32 + r32;
#pragma unroll
                for (int kk = 0; kk < 2 * tt + 2; ++kk) { bf16x8 wf = wfr[t2][kk];
                    if (kk >= 2 * tt) {
#pragma unroll
                        for (int e = 0; e < 8; ++e) if (16 * kk + 8 * hi + e > tl) wf[e] = 0; }
                    acc[0][t2] = __builtin_amdgcn_mfma_f32_32x32x16_bf16(af[0][kk], wf, acc[0][t2], 0, 0, 0);
                    acc[1][t2] = __builtin_amdgcn_mfma_f32_32x32x16_bf16(af[1][kk], wf, acc[1][t2], 0, 0, 0); } }
#pragma unroll
            for (int t2 = 0; t2 < 2; ++t2)
#pragma unroll
                for (int dt = 0; dt < 2; ++dt) { LAS unsigned char* e = LT + (32 * t2 + r32) * LTP + (32 * dt + 16 * hi) * 4;
#pragma unroll
                    for (int q = 0; q < 4; ++q) *(LAS f32x4*)(e + 16 * q) = (f32x4){acc[dt][t2][4 * q], acc[dt][t2][4 * q + 1], acc[dt][t2][4 * q + 2], acc[dt][t2][4 * q + 3]}; }
            const int ch = lane & 7, rr = lane >> 3;
            v4u uu[8], gg[8]; float bsr[8];
#pragma unroll
            for (int i = 0; i < 8; ++i) { const int tl = 64 * ps + rr + 8 * i; const size_t row = R0 + tl; const int col = cb + 8 * ch;
                uu[i] = __builtin_nontemporal_load((const v4u*)(U + row * 1024 + col)); gg[i] = __builtin_nontemporal_load((const v4u*)(GA + row * 1024 + col)); bsr[i] = bs[hd * 128 + tl]; }
            asm volatile("" : "+v"(uu[0]), "+v"(uu[1]), "+v"(uu[2]), "+v"(uu[3]), "+v"(uu[4]), "+v"(uu[5]), "+v"(uu[6]), "+v"(uu[7]), "+v"(gg[0]), "+v"(gg[1]), "+v"(gg[2]), "+v"(gg[3]), "+v"(gg[4]), "+v"(gg[5]), "+v"(gg[6]), "+v"(gg[7]));
#pragma unroll
            for (int i = 0; i < 8; ++i) { const int tloc = rr + 8 * i; const size_t row = R0 + 64 * ps + tloc; const int col = cb + 8 * ch; const float bsv = bsr[i];
                const f32x4 e0 = *(const LAS f32x4*)(LT + tloc * LTP + ch * 32), e1 = *(const LAS f32x4*)(LT + tloc * LTP + ch * 32 + 16);
                v4u w; w.x = pk2(bflo(uu[i].x) * (e0[0] + bsv) * bflo(gg[i].x), bfhi(uu[i].x) * (e0[1] + bsv) * bfhi(gg[i].x)); w.y = pk2(bflo(uu[i].y) * (e0[2] + bsv) * bflo(gg[i].y), bfhi(uu[i].y) * (e0[3] + bsv) * bfhi(gg[i].y));
                w.z = pk2(bflo(uu[i].z) * (e1[0] + bsv) * bflo(gg[i].z), bfhi(uu[i].z) * (e1[1] + bsv) * bfhi(gg[i].z)); w.w = pk2(bflo(uu[i].w) * (e1[2] + bsv) * bflo(gg[i].w), bfhi(uu[i].w) * (e1[3] + bsv) * bfhi(gg[i].w));
                *(v4u*)(Y + row * 2048 + col) = w; }
        }
    }
    __syncthreads();
}

__device__ __forceinline__ void fox_scan(const Args& a, LAS unsigned char* lds, int bh, int tid, int lane, int wid) {
    const float* LF = (const float*)(a.ws + WS_LF) + (size_t)bh * SEQ; float* NBg = (float*)(a.ws + WS_NB) + (size_t)bh * SEQ; LAS float* wt = (LAS float*)lds;
    const f32x4 x0 = *(const f32x4*)(LF + 8 * tid), x1 = *(const f32x4*)(LF + 8 * tid + 4);
    float v[8] = {x0[0], x0[1], x0[2], x0[3], x1[0], x1[1], x1[2], x1[3]};
#pragma unroll
    for (int i = 1; i < 8; ++i) v[i] += v[i - 1];
    const float tot = v[7]; float x = tot;
#pragma unroll
    for (int o = 1; o < 64; o <<= 1) { const float y = __shfl_up(x, o); if (lane >= o) x += y; }
    if (lane == 63) wt[wid] = x;
    __syncthreads();
    float off = x - tot;
    for (int w = 0; w < wid; ++w) off += wt[w];
    f32x4 o0, o1;
#pragma unroll
    for (int i = 0; i < 4; ++i) { o0[i] = -(off + v[i]) * 1.4426950408889634f; o1[i] = -(off + v[4 + i]) * 1.4426950408889634f; }
    *(f32x4*)(NBg + 8 * tid) = o0; *(f32x4*)(NBg + 8 * tid + 4) = o1;
    __syncthreads();
}

constexpr int N_PHASES = 10;
__global__ void __launch_bounds__(NTHR, 2) fwd_megakernel(Args args) {
    extern __shared__ __attribute__((aligned(16))) unsigned char lds_raw[];
    LAS unsigned char* lds = (LAS unsigned char*)lds_raw;
    const int G = gridDim.x, bx = blockIdx.x, vcu = (G % 8 == 0) ? (bx % 8) * (G / 8) + bx / 8 : bx;
    unsigned char* ws = args.ws;
    volatile LAS unsigned* bst = (volatile LAS unsigned*)(lds + LDS_PHASE);
    if (threadIdx.x < 2) bst[threadIdx.x] = 0u;
    __syncthreads();
    const XcdBarrier bar = xcd_barrier_post((unsigned*)(ws + WS_BAR), bst);
    if (args.ph_lo < 0) cg::this_grid().sync();
    for (int idx = args.ph_lo; idx < args.ph_hi; ++idx) {
        const int ph = (PROBE_DUP >= 0 && idx > PROBE_DUP) ? (idx <= PROBE_DUP + PROBE_REP ? PROBE_DUP : idx - PROBE_REP) : idx; const bool dup_pass = (PROBE_DUP >= 0 && idx > PROBE_DUP && idx <= PROBE_DUP + PROBE_REP); (void)dup_pass;
        int tid = threadIdx.x; asm volatile("" : "+v"(tid));
        const int lane = tid & 63, wave = __builtin_amdgcn_readfirstlane(tid >> 6);
#ifndef NO_P0
        if (ph == 0) p0_prologue(args, lds, vcu, G, wave, lane, dup_pass); else
#endif
        if (false) {}
        else if (ph == 9) p_final(args, vcu, G, wave, lane);
        else {
            const int l = (ph - 1) >> 2, sub = (ph - 1) & 3;
#ifndef NO_P1
            if (sub == 0 && l == 0) { mod_combine(args, bx, G, tid); xcd_barrier(bar); }
            if (sub == 0) p1_modnorm(args, lds, l, args.in[0], l == 0 ? (const bf16*)nullptr : (const bf16*)(ws + WS_T0), vcu, G, tid, wave, lane);
            else
#endif
            if (sub == 1) {
#ifndef NO_GIN
                pg8::Gemm g{(const pg8::bf16_t*)(ws + WS_H), (const pg8::bf16_t*)(ws + WS_WIN) + (size_t)l * NPAD * DM, M, NPAD, DM};
                pg8::StaticOrder S; S.init(M, NPAD, G, bx);
                if (!dup_pass) for (int bh = bx; bh < 64; bh += G) fox_scan(args, lds, bh, tid, lane, wave);
                pg8::EpiIn E{(pg8::bf16_t*)(ws + WS_Z), (float*)(ws + WS_STATP), attn_body::C2, (unsigned*)(ws + WS_KN2) + l * 128};
                pg8::gemm_phase<pg8::EpiIn, pg8::StaticOrder, true, true>(lds, g, S, E, tid);
#endif
            } else if (sub == 2) {
#ifndef NO_GMLP
                if (!(dup_pass && PROBE_PART == 2)) gmlp_phase(args, lds, l, vcu, G, wave, lane);
#endif
#ifndef NO_ATTN
                const attn_body::bf16* Zb = (const attn_body::bf16*)(ws + WS_Z);
                constexpr long QOFF = (long)WS_Z + 3L * M * 1024 * 2;
                const attn_body::AttnTensors AT{Zb + (size_t)3 * M * 1024, (long)M * 1024, (long)WS_Y + 2048 - QOFF, (long)WS_NB - QOFF};
                if (!(dup_pass && PROBE_PART == 1)) attn_body::attn_phase<20>((char*)lds_raw, AT, G, bx, tid, (unsigned*)(ws + WS_QCTR) + l + (dup_pass ? 2 : 0), (const unsigned*)(ws + WS_KN2) + l * 128);
#endif
            } else {
#ifndef NO_GOUT
                pg8::Gemm g{(const pg8::bf16_t*)(ws + WS_Y), (const pg8::bf16_t*)(ws + WS_WOUT) + (size_t)l * DM * DM, M, DM, DM};
                pg8::StaticOrder S; S.init(M, DM, G, bx);
                pg8::EpiOut E{(pg8::bf16_t*)(ws + (l == 0 ? WS_T0 : WS_H)), (const float*)(ws + WS_MODF) + (size_t)l * 4 * 6144 + 4096};
                pg8::gemm_phase<pg8::EpiOut, pg8::StaticOrder, true, true>(lds, g, S, E, tid);
#endif
            }
        }
        if (idx + 1 < args.ph_hi) xcd_barrier(bar);
    }
}

extern "C" void kernel_launch(void* const* d_in, const int* in_sizes, int n_in, void* d_out, int out_size, void* d_ws, size_t ws_size, hipStream_t stream) {
    static int grid = 0;
    if (grid == 0) {
        if (n_in != 13 || out_size != M * DM || ws_size < WS_END) { fprintf(stderr, "kernel_launch: unexpected shapes (n_in %d, out %d, ws %zu)\n", n_in, out_size, ws_size); grid = -1; return; }
        int dev = 0, cus = 0, per_cu = 0;
        hipGetDevice(&dev); hipDeviceGetAttribute(&cus, hipDeviceAttributeMultiprocessorCount, dev);
        if (hipFuncSetAttribute((const void*)fwd_megakernel, hipFuncAttributeMaxDynamicSharedMemorySize, LDS_BYTES) != hipSuccess) { fprintf(stderr, "kernel_launch: hipFuncSetAttribute failed\n"); grid = -1; return; }
        if (hipOccupancyMaxActiveBlocksPerMultiprocessor(&per_cu, (const void*)fwd_megakernel, NTHR, LDS_BYTES) != hipSuccess || per_cu < 1) { fprintf(stderr, "kernel_launch: occupancy query says %d\n", per_cu); per_cu = 1; }
        (void)hipGetLastError();
        grid = cus;
        fprintf(stderr, "kernel_launch: cus %d per_cu %d grid %d\n", cus, per_cu, grid);
    }
    if (grid < 0) return;
    if (hipMemsetAsync((char*)d_ws + WS_BAR, 0, BAR_ZERO_BYTES, stream) != hipSuccess) { fprintf(stderr, "kernel_launch: memset failed\n"); return; }
    Args a{};
    for (int i = 0; i < 13; ++i) a.in[i] = (const float*)d_in[i];
    a.out = (float*)d_out; a.ws = (unsigned char*)d_ws;
#if MK_N_LAUNCHES == 1
    a.ph_lo = 0; a.ph_hi = N_PHASES + (PROBE_DUP >= 0 ? PROBE_REP : 0);
    void* kargs[] = {&a};
    hipError_t e = hipLaunchCooperativeKernel((const void*)fwd_megakernel, dim3(grid), dim3(NTHR), kargs, LDS_BYTES, stream);
    if (e != hipSuccess) fprintf(stderr, "kernel_launch: cooperative launch failed: %s (grid %d)\n", hipGetErrorString(e), grid);
#else
    for (int ph = 0; ph < N_PHASES; ++ph) { a.ph_lo = ph; a.ph_hi = ph + 1; hipLaunchKernelGGL(fwd_megakernel, dim3(grid), dim3(NTHR), LDS_BYTES, stream, a); }
#endif
}
```
